# Optimizing an MI355X kernel written in HIP

```python
import math
import jax, jax.numpy as jnp
from jax import lax
import numpy as np

D_MODEL = 1024
BATCH = 16
SEQ = 2048
DEPTH = 4

N_MIXERS = 2
QK_DIM = 64
V_DIM = 2 * QK_DIM
N_HEADS = D_MODEL // V_DIM
ROPE_DIM = QK_DIM // 4
ROPE_THETA = 500000.0
Q_BLOCK = 128
POOL_WINDOWS = (2, 4, 8, 16)
N_POOL_GROUPS = len(POOL_WINDOWS)
POOL_GROUP = D_MODEL // N_POOL_GROUPS
D_FF = 4 * D_MODEL
EPS = 1e-6
LAMBDA_STD = 0.1

kernel_name = "hybrid_diffattn_multiscale_pool_encoder"


def rmsnorm(x, g):
    xf = x.astype(jnp.float32)
    y = xf * lax.rsqrt(jnp.mean(xf * xf, axis=-1, keepdims=True) + EPS) * g.astype(jnp.float32)
    return y.astype(x.dtype)


def lambda_init_fn(layer_idx):
    return 0.8 - 0.6 * math.exp(-0.3 * layer_idx)


def rope_tables(positions):
    inv_freq = ROPE_THETA ** (-jnp.arange(0, ROPE_DIM, 2, dtype=jnp.float32) / ROPE_DIM)
    ang = positions.astype(jnp.float32)[..., None] * inv_freq
    return jnp.cos(ang)[:, None], jnp.sin(ang)[:, None]


def partial_rope(x, cos, sin):
    half = ROPE_DIM // 2
    xf = x.astype(jnp.float32)
    x1, x2, xp = xf[..., :half], xf[..., half:ROPE_DIM], xf[..., ROPE_DIM:]
    rot = jnp.concatenate([x1 * cos - x2 * sin, x2 * cos + x1 * sin, xp], axis=-1)
    return rot.astype(x.dtype)


def diff_attention(h, cos, sin, w_qkv, w_o, q_gain, k_gain, lam_q1, lam_k1, lam_q2, lam_k2,
                   sub_gain, lambda_init):
    B, S, D = h.shape
    qkv = h @ w_qkv
    q, k, v = qkv[..., :D], qkv[..., D:2 * D], qkv[..., 2 * D:]
    q = q.reshape(B, S, N_HEADS, 2, QK_DIM).transpose(3, 0, 2, 1, 4)
    k = k.reshape(B, S, N_HEADS, 2, QK_DIM).transpose(3, 0, 2, 1, 4)
    v = v.reshape(B, S, N_HEADS, V_DIM).transpose(0, 2, 1, 3)
    q = partial_rope(rmsnorm(q, q_gain), cos, sin)
    k = partial_rope(rmsnorm(k, k_gain), cos, sin)
    scale = 1.0 / math.sqrt(QK_DIM)
    lam = (jnp.exp(jnp.sum(lam_q1.astype(jnp.float32) * lam_k1.astype(jnp.float32)))
           - jnp.exp(jnp.sum(lam_q2.astype(jnp.float32) * lam_k2.astype(jnp.float32)))
           + lambda_init)
    n_blk = S // Q_BLOCK
    qb = q.reshape(2, B, N_HEADS, n_blk, Q_BLOCK, QK_DIM).transpose(3, 0, 1, 2, 4, 5)

    def attend_block(q_blk):
        s = jnp.einsum('mbhqd,mbhkd->mbhqk', q_blk, k).astype(jnp.float32) * scale
        p = jax.nn.softmax(s, axis=-1)
        a = p[0] - lam * p[1]
        return jnp.einsum('bhqk,bhkv->bhqv', a.astype(v.dtype), v)

    o = lax.map(attend_block, qb)
    o = o.transpose(1, 2, 0, 3, 4).reshape(B, N_HEADS, S, V_DIM)
    o = rmsnorm(o, sub_gain) * (1.0 - lambda_init)
    o = o.transpose(0, 2, 1, 3).reshape(B, S, N_HEADS * V_DIM)
    return o @ w_o


def multiscale_pool(h, w_group, ch_scale):
    B, S, D = h.shape
    hf = h.astype(jnp.float32)
    cs = jnp.concatenate([jnp.zeros((B, 1, D), jnp.float32), jnp.cumsum(hf, axis=1)], axis=1)
    t = jnp.arange(S)
    pooled = []
    for g, w in enumerate(POOL_WINDOWS):
        lo = jnp.clip(t - w // 2, 0, S)
        hi = jnp.clip(t + w // 2, 0, S)
        csg = cs[..., g * POOL_GROUP:(g + 1) * POOL_GROUP]
        tot = jnp.take(csg, hi, axis=1) - jnp.take(csg, lo, axis=1)
        cnt = (hi - lo).astype(jnp.float32)[None, :, None]
        pooled.append(tot / cnt)
    mean = jnp.concatenate(pooled, axis=-1)
    diff = (mean - hf).astype(h.dtype).reshape(B, S, N_POOL_GROUPS, POOL_GROUP)
    y = jnp.einsum('bsgc,gcd->bsgd', diff, w_group).reshape(B, S, D)
    return y * ch_scale


def sqrelu_mlp(h, w1, w2):
    return jnp.square(jax.nn.relu(h @ w1)) @ w2


def setup_inputs(seed: int = 0) -> dict:
    key = jax.random.key(seed)
    ks = jax.random.split(key, 20)
    n_attn = (DEPTH + N_MIXERS - 1) // N_MIXERS
    n_pool = DEPTH // N_MIXERS
    f32 = jnp.float32
    nrm = lambda k, shape, s: jax.random.normal(k, shape, f32) * s
    x = jax.random.normal(ks[0], (BATCH, SEQ, D_MODEL), f32)
    offsets = jax.random.randint(ks[1], (BATCH, 1), 0, 4096, dtype=jnp.int32)
    positions = (offsets + jnp.arange(SEQ, dtype=jnp.int32)[None, :]).astype(jnp.int32)
    return {
        "x": x,
        "positions": positions,
        "norm_mix": 1.0 + nrm(ks[2], (DEPTH, D_MODEL), 0.05),
        "norm_mlp": 1.0 + nrm(ks[3], (DEPTH, D_MODEL), 0.05),
        "attn_w_qkv": nrm(ks[4], (n_attn, D_MODEL, 3 * D_MODEL), D_MODEL ** -0.5),
        "attn_w_o": nrm(ks[5], (n_attn, N_HEADS * V_DIM, D_MODEL), (N_HEADS * V_DIM) ** -0.5),
        "attn_q_gain": 1.0 + nrm(ks[6], (n_attn, QK_DIM), 0.05),
        "attn_k_gain": 1.0 + nrm(ks[7], (n_attn, QK_DIM), 0.05),
        "attn_lam_q1": nrm(ks[8], (n_attn, QK_DIM), LAMBDA_STD),
        "attn_lam_k1": nrm(ks[9], (n_attn, QK_DIM), LAMBDA_STD),
        "attn_lam_q2": nrm(ks[10], (n_attn, QK_DIM), LAMBDA_STD),
        "attn_lam_k2": nrm(ks[11], (n_attn, QK_DIM), LAMBDA_STD),
        "attn_sub_gain": 1.0 + nrm(ks[12], (n_attn, V_DIM), 0.05),
        "pool_w": nrm(ks[13], (n_pool, N_POOL_GROUPS, POOL_GROUP, POOL_GROUP), POOL_GROUP ** -0.5),
        "pool_scale": 0.5 + nrm(ks[14], (n_pool, D_MODEL), 0.05),
        "mlp_w1": nrm(ks[15], (DEPTH, D_MODEL, D_FF), D_MODEL ** -0.5),
        "mlp_w2": nrm(ks[16], (DEPTH, D_FF, D_MODEL), D_FF ** -0.5),
    }


def reference(x, positions, norm_mix, norm_mlp, attn_w_qkv, attn_w_o, attn_q_gain, attn_k_gain,
              attn_lam_q1, attn_lam_k1, attn_lam_q2, attn_lam_k2, attn_sub_gain,
              pool_w, pool_scale, mlp_w1, mlp_w2):
    cos, sin = rope_tables(positions)
    for i in range(DEPTH):
        j = i // N_MIXERS
        h = rmsnorm(x, norm_mix[i])
        if i % N_MIXERS == 0:
            y = diff_attention(h, cos, sin, attn_w_qkv[j], attn_w_o[j], attn_q_gain[j], attn_k_gain[j],
                               attn_lam_q1[j], attn_lam_k1[j], attn_lam_q2[j], attn_lam_k2[j],
                               attn_sub_gain[j], lambda_init_fn(i))
        else:
            y = multiscale_pool(h, pool_w[j], pool_scale[j])
        x = x + y.astype(x.dtype)
        h = rmsnorm(x, norm_mlp[i])
        x = x + sqrelu_mlp(h, mlp_w1[i], mlp_w2[i]).astype(x.dtype)
    return x
```

```cpp
#include <hip/hip_runtime.h>
#include <hip/hip_cooperative_groups.h>
#include <cstdio>
#include <cstdint>
#include <cmath>
namespace cg = cooperative_groups;

#ifndef MK_PER_PHASE
#define MK_PER_PHASE 0
#endif
#ifndef MK_CG_FIRST
#define MK_CG_FIRST 1
#endif

constexpr int D_MODEL = 1024, BATCH = 16, SEQ = 2048, DEPTH = 4, NH = 8, FF = 4096;
constexpr int M = BATCH * SEQ;
constexpr float EPS = 1e-6f;

__device__ __forceinline__ float xsum16(float v) {
    auto r = __builtin_amdgcn_permlane16_swap(__float_as_uint(v), __float_as_uint(v), false, false); return __uint_as_float(r[0]) + __uint_as_float(r[1]); }
__device__ __forceinline__ float xsum32(float v) {
    auto r = __builtin_amdgcn_permlane32_swap(__float_as_uint(v), __float_as_uint(v), false, false); return __uint_as_float(r[0]) + __uint_as_float(r[1]); }
__device__ __forceinline__ float xget16(float v, int lane) {
    auto r = __builtin_amdgcn_permlane16_swap(__float_as_uint(v), __float_as_uint(v), false, false); return __uint_as_float(((lane >> 4) & 1) ? r[0] : r[1]); }
__device__ __forceinline__ float rowsum16(float v) {
    v += __builtin_bit_cast(float, __builtin_amdgcn_update_dpp(0, __builtin_bit_cast(int, v), 0xB1, 0xF, 0xF, true));
    v += __builtin_bit_cast(float, __builtin_amdgcn_update_dpp(0, __builtin_bit_cast(int, v), 0x4E, 0xF, 0xF, true));
    v += __builtin_bit_cast(float, __builtin_amdgcn_update_dpp(0, __builtin_bit_cast(int, v), 0x141, 0xF, 0xF, true));
    v += __builtin_bit_cast(float, __builtin_amdgcn_update_dpp(0, __builtin_bit_cast(int, v), 0x140, 0xF, 0xF, true));
    return v; }

namespace pg8 {
#define PG8_LAS __attribute__((address_space(3)))
typedef unsigned short bf16_t;
typedef short bf16x8 __attribute__((ext_vector_type(8)));
typedef float f32x4 __attribute__((ext_vector_type(4)));
typedef unsigned u32x4 __attribute__((ext_vector_type(4)));
constexpr int BM = 256, BK = 64, HALF = 128, HTB = HALF * BK * 2, STAGE_BYTES = 8 * HTB, NXCD = 8, WGM = 8;

__host__ __device__ __forceinline__ int lds_byte(int r, int c) { const int st = (r >> 4) * 2 + (c >> 5), rr = r & 15, cc = c & 31, ob = rr * 64 + cc * 2; return st * 1024 + (ob ^ (((ob >> 9) & 1) << 5)); }
__host__ __device__ __forceinline__ void stage_rc(int b, int& R, int& C) { const int st = b / 1024, sb = b % 1024, swz = sb ^ (((sb >> 9) & 1) << 5); R = (st >> 1) * 16 + swz / 64; C = (st & 1) * 32 + (swz % 64) / 2; }
__host__ __device__ __forceinline__ int perm32(int rho) { const int n = rho >> 4, i = rho & 15; return 8 * (i >> 2) + 4 * n + (i & 3); }

struct Unit { int pm, pn; };
__host__ __device__ __forceinline__ size_t aimg_off(int row, int col, int nkt) { const int rl = row & 255;
    return ((((size_t)(row >> 8) * nkt + (col >> 6)) * 2 + (rl >> 7)) * 16384 + (size_t)lds_byte(rl & 127, col & 63)) >> 1; }
struct Gemm { const bf16_t* A; const bf16_t* Bt; int M, N, K, lda, apn, aimg; };

struct StaticOrder {
    int nM, nN, nwg, G, c;
    __host__ __device__ void init(int M_, int N_, int G_, int c_) { nM = M_ / BM; nN = N_ / BM; nwg = nM * nN; G = G_; c = c_; }
    __host__ __device__ bool next(int i, Unit& u) const {
        const long L = (long)i * G + c; if (L >= nwg) return false;
        int wgid = (int)L; { const int q = nwg / NXCD, r = nwg % NXCD, xcd = wgid % NXCD, off = wgid / NXCD; wgid = (xcd < r ? xcd * (q + 1) : r * (q + 1) + (xcd - r) * q) + off; }
        const int nig = WGM * nN, gid = wgid / nig, fm = gid * WGM, gsz = (nM - fm) < WGM ? (nM - fm) : WGM;
        u.pm = fm + ((wgid % nig) % gsz); u.pn = (wgid % nig) / gsz; return true;
    }
};

__device__ __forceinline__ unsigned cvt_pk_bf16(float lo, float hi) { unsigned r; asm volatile("v_cvt_pk_bf16_f32 %0, %1, %2" : "=v"(r) : "v"(lo), "v"(hi)); return r; }
__device__ __forceinline__ float rstd_row(const float* part, int row) {
    const f32x4* p = (const f32x4*)(part + (size_t)row * 16); const f32x4 a = p[0], b = p[1], c = p[2], d = p[3];
    const float s = (((a[0] + a[1]) + (a[2] + a[3])) + ((b[0] + b[1]) + (b[2] + b[3]))) + (((c[0] + c[1]) + (c[2] + c[3])) + ((d[0] + d[1]) + (d[2] + d[3])));
    return __builtin_amdgcn_rsqf(s * (1.0f / D_MODEL) + EPS);
}


struct EpiResid {
    static constexpr bool PERM = true, HEADPERM = false;
    float* out; bf16_t* xb; float* ssq; int ldc; bool last; const float* rs2src;
    __device__ __forceinline__ void begin_unit(const Unit& u, PG8_LAS float* t0, int par, int tid) const { if (rs2src && tid < 256) { const float r = rstd_row(rs2src, u.pm * BM + tid); t0[par * 256 + tid] = r * r; } }
    __device__ __forceinline__ void operator()(const f32x4 (&acc)[2][2][4][2], const Unit& u, int wr, int wc, int fr, int fq, const PG8_LAS float* t0, int par) const {
        const PG8_LAS float* tb = t0 + par * 256;
        const int row0 = u.pm * BM + wr * 64 + fr, col0 = u.pn * BM + wc * 32 + 8 * fq;
        u32x4 xin[2][4][2];
#pragma unroll
        for (int ai = 0; ai < 2; ++ai)
#pragma unroll
            for (int m = 0; m < 4; ++m)
#pragma unroll
                for (int bj = 0; bj < 2; ++bj) xin[ai][m][bj] = *(const u32x4*)(xb + aimg_off(row0 + ai * HALF + m * 16, col0 + bj * HALF, ldc / 64));
        asm volatile("" ::: "memory");
#pragma unroll
        for (int ai = 0; ai < 2; ++ai) {
#pragma unroll
            for (int m = 0; m < 4; ++m) {
                int row = row0 + ai * HALF + m * 16; asm volatile("" : "+v"(row)); float ss = 0.f; const float r2 = rs2src ? tb[row - u.pm * BM] : 1.0f;
#pragma unroll
                for (int bj = 0; bj < 2; ++bj) {
                    const size_t off = (size_t)row * ldc + col0 + bj * HALF, offx = aimg_off(row, col0 + bj * HALF, ldc / 64);
                    const u32x4 xw = xin[ai][m][bj];
                    f32x4 b0, b1;
                    b0[0] = __uint_as_float(xw.x << 16); b0[1] = __uint_as_float(xw.x & 0xffff0000u); b0[2] = __uint_as_float(xw.y << 16); b0[3] = __uint_as_float(xw.y & 0xffff0000u);
                    b1[0] = __uint_as_float(xw.z << 16); b1[1] = __uint_as_float(xw.z & 0xffff0000u); b1[2] = __uint_as_float(xw.w << 16); b1[3] = __uint_as_float(xw.w & 0xffff0000u);
                    const f32x4 v0 = acc[ai][bj][m][0] * r2 + b0, v1 = acc[ai][bj][m][1] * r2 + b1;
                    if (last) { *(f32x4*)(out + off) = v0; *(f32x4*)(out + off + 4) = v1; }
                    else {
                        ss += (v0[0] * v0[0] + v0[1] * v0[1]) + (v0[2] * v0[2] + v0[3] * v0[3]) + (v1[0] * v1[0] + v1[1] * v1[1]) + (v1[2] * v1[2] + v1[3] * v1[3]);
                        u32x4 w; w.x = cvt_pk_bf16(v0[0], v0[1]); w.y = cvt_pk_bf16(v0[2], v0[3]); w.z = cvt_pk_bf16(v1[0], v1[1]); w.w = cvt_pk_bf16(v1[2], v1[3]); *(u32x4*)(xb + offx) = w;
                    }
                }
                if (!last) { ss = xsum16(ss); ss = xsum32(ss); if (fq == 0) ssq[(size_t)row * 16 + u.pn * 4 + wc] = ss; }
            }
        }
    }
};
struct EpiUp {
    static constexpr bool PERM = true, HEADPERM = false;
    bf16_t* H; int ldc; const float* ssq;
    __device__ __forceinline__ void begin_unit(const Unit&, PG8_LAS float*, int, int) const {}
    __device__ __forceinline__ void operator()(const f32x4 (&acc)[2][2][4][2], const Unit& u, int wr, int wc, int fr, int fq, const PG8_LAS float*, int) const {
        const int row0 = u.pm * BM + wr * 64 + fr, col0 = u.pn * BM + wc * 32 + 8 * fq;
#pragma unroll
        for (int ai = 0; ai < 2; ++ai)
#pragma unroll
            for (int m = 0; m < 4; ++m) {
                const int row = row0 + ai * HALF + m * 16;
#pragma unroll
                for (int bj = 0; bj < 2; ++bj) {
                    f32x4 v0 = acc[ai][bj][m][0], v1 = acc[ai][bj][m][1];
#pragma unroll
                    for (int j = 0; j < 4; ++j) { const float a = fmaxf(v0[j], 0.f), b = fmaxf(v1[j], 0.f); v0[j] = a * a; v1[j] = b * b; }
                    u32x4 w; w.x = cvt_pk_bf16(v0[0], v0[1]); w.y = cvt_pk_bf16(v0[2], v0[3]); w.z = cvt_pk_bf16(v1[0], v1[1]); w.w = cvt_pk_bf16(v1[2], v1[3]);
                    *(u32x4*)(H + aimg_off(row, col0 + bj * HALF, ldc / 64)) = w;
                }
            }
    }
};
struct EpiQKV {
    static constexpr bool PERM = true, HEADPERM = true;
    bf16_t* Q; size_t tstride; const float* ssq; const float* rope; const float* qg; const float* kg; float qscale;
    __device__ __forceinline__ void begin_unit(const Unit& u, PG8_LAS float* t0, int par, int tid) const {
        if (tid < 256) { const int row = u.pm * BM + tid; t0[par * 256 + tid] = rstd_row(ssq, row);
            if ((u.pn >> 2) < 2) { const f32x4* rp = (const f32x4*)(rope + (size_t)row * 16); const f32x4 a = rp[0], b = rp[1], c = rp[2], d = rp[3];
                typedef __fp16 h2 __attribute__((ext_vector_type(2)));
                u32x4 w0, w1;
                w0.x = __builtin_bit_cast(unsigned, __builtin_amdgcn_cvt_pkrtz(a[0], a[1])); w0.y = __builtin_bit_cast(unsigned, __builtin_amdgcn_cvt_pkrtz(a[2], a[3]));
                w0.z = __builtin_bit_cast(unsigned, __builtin_amdgcn_cvt_pkrtz(b[0], b[1])); w0.w = __builtin_bit_cast(unsigned, __builtin_amdgcn_cvt_pkrtz(b[2], b[3]));
                w1.x = __builtin_bit_cast(unsigned, __builtin_amdgcn_cvt_pkrtz(c[0], c[1])); w1.y = __builtin_bit_cast(unsigned, __builtin_amdgcn_cvt_pkrtz(c[2], c[3]));
                w1.z = __builtin_bit_cast(unsigned, __builtin_amdgcn_cvt_pkrtz(d[0], d[1])); w1.w = __builtin_bit_cast(unsigned, __builtin_amdgcn_cvt_pkrtz(d[2], d[3]));
                PG8_LAS u32x4* dst = (PG8_LAS u32x4*)((PG8_LAS char*)t0 + 2048 + par * 8192 + tid * 32); dst[0] = w0; dst[1] = w1; } }
    }
    __device__ __forceinline__ void operator()(const f32x4 (&acc)[2][2][4][2], const Unit& u, int wr, int wc, int fr, int fq, const PG8_LAS float* t0, int par) const {
        const PG8_LAS float* tb = t0 + par * 256; const PG8_LAS char* rtab = (const PG8_LAS char*)t0 + 2048 + par * 8192;
        const int type = u.pn >> 2;
        bf16_t* dst = Q + (size_t)type * tstride;
        const int colw = (u.pn & 3) * 256 + wc * 64 + 8 * fq;
        const int row0 = u.pm * BM + wr * 64 + fr;
        if (type == 2) {
#pragma unroll
            for (int ai = 0; ai < 2; ++ai)
#pragma unroll
                for (int m = 0; m < 4; ++m) {
                    const int row = row0 + ai * HALF + m * 16; const float rstd = tb[row - u.pm * BM];
#pragma unroll
                    for (int bj = 0; bj < 2; ++bj) {
                        const f32x4 v0 = acc[ai][bj][m][0] * rstd, v1 = acc[ai][bj][m][1] * rstd;
                        u32x4 w; w.x = cvt_pk_bf16(v0[0], v0[1]); w.y = cvt_pk_bf16(v0[2], v0[3]); w.z = cvt_pk_bf16(v1[0], v1[1]); w.w = cvt_pk_bf16(v1[2], v1[3]);
                        { const int col = colw + 32 * bj, hd = col >> 7, dh = col & 127, key = row & (SEQ - 1), kk = key & 63;
                          const size_t byte = ((size_t)(((row >> 11) * 8 + hd) * 32 + (key >> 6)) << 14) + (size_t)(((kk >> 3) * 4 + (dh >> 5)) * 512 + ((kk & 7) * 32 + (dh & 31)) * 2);
                          *(u32x4*)((char*)dst + byte) = w; }
                    }
                }
        } else {
            const float* gp = type == 0 ? qg : kg; const float gs = type == 0 ? qscale : 1.0f;
            f32x4 gv[2][2];
#pragma unroll
            for (int bj = 0; bj < 2; ++bj)
#pragma unroll
                for (int n = 0; n < 2; ++n) gv[bj][n] = *(const f32x4*)(gp + 32 * bj + 8 * fq + 4 * n) * gs;
#pragma unroll
            for (int ai = 0; ai < 2; ++ai)
#pragma unroll
                for (int m = 0; m < 4; ++m) {
                    const int row = row0 + ai * HALF + m * 16; const float rstd = tb[row - u.pm * BM];
                    f32x4 t[2][2]; float ss = 0.f;
#pragma unroll
                    for (int bj = 0; bj < 2; ++bj)
#pragma unroll
                        for (int n = 0; n < 2; ++n) { const f32x4 x = acc[ai][bj][m][n]; ss += (x[0] * x[0] + x[1] * x[1]) + (x[2] * x[2] + x[3] * x[3]); }
                    ss = xsum16(ss); ss = xsum32(ss);
                    const float sc = rstd * __builtin_amdgcn_rsqf(rstd * rstd * ss * (1.0f / 64.0f) + EPS);
#pragma unroll
                    for (int bj = 0; bj < 2; ++bj)
#pragma unroll
                        for (int n = 0; n < 2; ++n) t[bj][n] = acc[ai][bj][m][n] * (gv[bj][n] * sc);
                    const PG8_LAS char* rp = rtab + (row - u.pm * BM) * 32;
#pragma unroll
                    for (int n = 0; n < 2; ++n) {
                        f32x4 p;
#pragma unroll
                        for (int j = 0; j < 4; ++j) p[j] = xget16(t[0][n][j], fq << 4);
                        if (fq < 2) {
                            typedef __fp16 h4 __attribute__((ext_vector_type(4)));
                            const h4 ch = *(const PG8_LAS h4*)(rp + 8 * n), sh = *(const PG8_LAS h4*)(rp + 16 + 8 * n);
                            const f32x4 cs = {(float)ch[0], (float)ch[1], (float)ch[2], (float)ch[3]}, sn = {(float)sh[0], (float)sh[1], (float)sh[2], (float)sh[3]};
                            t[0][n] = (fq == 0) ? (t[0][n] * cs - p * sn) : (t[0][n] * cs + p * sn);
                        }
                    }
#pragma unroll
                    for (int bj = 0; bj < 2; ++bj) {
                        const f32x4 v0 = t[bj][0], v1 = t[bj][1];
                        u32x4 w; w.x = cvt_pk_bf16(v0[0], v0[1]); w.y = cvt_pk_bf16(v0[2], v0[3]); w.z = cvt_pk_bf16(v1[0], v1[1]); w.w = cvt_pk_bf16(v1[2], v1[3]);
                        if (type == 0) *(u32x4*)(dst + (size_t)row * D_MODEL + colw + 32 * bj) = w;
                        else { const int col = colw + 32 * bj, hd = col >> 7, dh = col & 127, key = row & (SEQ - 1), kk = key & 63;
                          const size_t byte = ((size_t)(((row >> 11) * 8 + hd) * 32 + (key >> 6)) << 14) + (size_t)(kk * 256 + ((dh * 2) ^ ((kk & 15) << 4)));
                          *(u32x4*)((char*)dst + byte) = w; }
                    }
                }
        }
    }
};

template <class Epi, class Sched>
__device__ __forceinline__ void gemm_phase(PG8_LAS unsigned char* lds, PG8_LAS float* tbl, const Gemm g, const Sched& S, const Epi& E) {
    int tid = threadIdx.x; asm volatile("" : "+v"(tid));
    const int wid = __builtin_amdgcn_readfirstlane(tid >> 6), lane = tid & 63, wr = wid >> 2, wc = wid & 3, fr = lane & 15, fq = lane >> 4;
    const int K = g.K, nt = K / BK, lda = g.lda;
    unsigned voffA[2], voffB[2];
#pragma unroll
    for (int i = 0; i < 2; ++i) { int R, C; stage_rc(tid * 16 + i * 8192, R, C);
        const int Rb = Epi::HEADPERM ? (64 * (R >> 5) + perm32(R & 31)) : (Epi::PERM ? ((R & ~31) + perm32(R & 31)) : R);
        voffA[i] = g.aimg ? (unsigned)(tid * 16 + i * 8192) : (unsigned)(R * lda + C) * 2u; (void)Rb; voffB[i] = (unsigned)(tid * 16 + i * 8192); }
    const size_t kstep = g.aimg ? 2 * (size_t)HTB : (size_t)(BK * 2);
    const size_t hstepA = g.aimg ? (size_t)HTB : (size_t)HALF * lda * 2, tstepA = g.aimg ? (size_t)(lda / 64) * 2 * HTB : 2 * (size_t)HALF * lda * 2;
    const size_t hstepB = (size_t)HTB, kstepB = 2 * (size_t)HTB, tstepB = (size_t)BM * K * 2;
    const unsigned ldsw = (unsigned)wid * 1024u;
    const int aoff = lds_byte(wr * 64 + fr, fq * 8), boff = lds_byte(wc * 32 + fr, fq * 8);
#define PG8_SA(b, h) (((b) * 2 + (h)) * HTB)
#define PG8_SB(b, h) ((4 + (b) * 2 + (h)) * HTB)
#define PG8_STAGE(bufoff, gbase, voff) do { _Pragma("unroll") for (int _i = 0; _i < 2; ++_i) \
        __builtin_amdgcn_global_load_lds((const unsigned*)((const char*)(gbase) + (voff)[_i]), (PG8_LAS unsigned*)(lds + (bufoff) + ldsw + _i * 8192), 16, 0, 0); } while (0)
#define PG8_LDA(dst, b, h) do { _Pragma("unroll") for (int m = 0; m < 4; ++m) _Pragma("unroll") for (int k = 0; k < 2; ++k) dst[m][k] = *(const PG8_LAS bf16x8*)(lds + PG8_SA(b, h) + aoff + m * 2048 + k * 1024); } while (0)
#define PG8_LDB(dst, b, h) do { _Pragma("unroll") for (int n = 0; n < 2; ++n) _Pragma("unroll") for (int k = 0; k < 2; ++k) dst[n][k] = *(const PG8_LAS bf16x8*)(lds + PG8_SB(b, h) + boff + n * 2048 + k * 1024); } while (0)
#define PG8_MMA(ai, bj, At, Bt) do { __builtin_amdgcn_s_setprio(1); _Pragma("unroll") for (int m = 0; m < 4; ++m) _Pragma("unroll") for (int n = 0; n < 2; ++n) _Pragma("unroll") for (int k = 0; k < 2; ++k) \
        acc[ai][bj][m][n] = __builtin_amdgcn_mfma_f32_16x16x32_bf16(Bt[n][k], At[m][k], acc[ai][bj][m][n], 0, 0, 0); __builtin_amdgcn_s_setprio(0); } while (0)
#define PG8_WAIT_V(n) asm volatile("s_waitcnt vmcnt(" #n ")" ::: "memory")
#define PG8_WAIT_L(n) asm volatile("s_waitcnt lgkmcnt(" #n ")" ::: "memory")
#define PG8_BAR __builtin_amdgcn_s_barrier()
#define PG8_SCHED __builtin_amdgcn_sched_barrier(0)
    Unit cur, nxt; int ui = 0;
    if (!S.next(0, cur)) return;
    f32x4 acc[2][2][4][2];
#pragma unroll
    for (int a = 0; a < 2; ++a)
#pragma unroll
        for (int b = 0; b < 2; ++b)
#pragma unroll
            for (int m = 0; m < 4; ++m)
#pragma unroll
                for (int n = 0; n < 2; ++n) acc[a][b][m][n] = (f32x4){0.f, 0.f, 0.f, 0.f};
    bf16x8 At[4][2], B0[2][2], B1[2][2];
    const char* cA = (const char*)g.A + (size_t)cur.pm * tstepA + (size_t)cur.pn * g.apn * 2; const char* cB = (const char*)g.Bt + (size_t)cur.pn * tstepB;
    E.begin_unit(cur, tbl, 0, tid);
    PG8_STAGE(PG8_SB(0, 0), cB, voffB); PG8_STAGE(PG8_SB(0, 1), cB + hstepB, voffB); PG8_STAGE(PG8_SA(0, 0), cA, voffA); PG8_STAGE(PG8_SA(0, 1), cA + hstepA, voffA);
    if (wr == 1) PG8_BAR;
    PG8_WAIT_V(2); PG8_BAR;
    PG8_STAGE(PG8_SB(1, 0), cB + kstepB, voffB); PG8_STAGE(PG8_SA(1, 0), cA + kstep, voffA); PG8_STAGE(PG8_SB(1, 1), cB + hstepB + kstepB, voffB);
    PG8_WAIT_V(6); PG8_BAR;
    for (;;) {
        const bool has_next = S.next(ui + 1, nxt);
        const char* nA = has_next ? (const char*)g.A + (size_t)nxt.pm * tstepA + (size_t)nxt.pn * g.apn * 2 : cA; const char* nB = has_next ? (const char*)g.Bt + (size_t)nxt.pn * tstepB : cB;
        for (int t = 0; t < nt; t += 2) {
            const bool last = (t == nt - 2);
            const char* a1 = cA + (size_t)(t + 1) * kstep;
            const char* a2 = last ? nA : cA + (size_t)(t + 2) * kstep; const char* b2 = last ? nB : cB + (size_t)(t + 2) * kstepB;
            const char* a3 = a2 + kstep; const char* b3 = b2 + kstepB;
            PG8_LDB(B0, 0, 0); PG8_LDB(B1, 0, 1); PG8_SCHED; PG8_LDA(At, 0, 0); PG8_STAGE(PG8_SA(1, 1), a1 + hstepA, voffA);
            PG8_WAIT_V(8); PG8_WAIT_L(0); PG8_BAR; PG8_MMA(0, 0, At, B0); PG8_MMA(0, 1, At, B1); PG8_BAR; PG8_SCHED;
            PG8_LDA(At, 0, 1); PG8_STAGE(PG8_SB(0, 0), b2, voffB); PG8_STAGE(PG8_SB(0, 1), b2 + hstepB, voffB); PG8_STAGE(PG8_SA(0, 0), a2, voffA);
            PG8_WAIT_V(8); PG8_WAIT_L(0); PG8_BAR; PG8_MMA(1, 0, At, B0); PG8_MMA(1, 1, At, B1); PG8_BAR; PG8_SCHED;
            PG8_LDB(B0, 1, 0); PG8_LDB(B1, 1, 1); PG8_SCHED; PG8_LDA(At, 1, 0); PG8_STAGE(PG8_SA(0, 1), a2 + hstepA, voffA);
            PG8_WAIT_V(8); PG8_WAIT_L(0); PG8_BAR; PG8_MMA(0, 0, At, B0); PG8_MMA(0, 1, At, B1); PG8_BAR; PG8_SCHED;
            PG8_LDA(At, 1, 1); PG8_STAGE(PG8_SB(1, 0), b3, voffB); PG8_STAGE(PG8_SB(1, 1), b3 + hstepB, voffB); PG8_STAGE(PG8_SA(1, 0), a3, voffA);
            PG8_WAIT_V(8); PG8_WAIT_L(0); PG8_BAR; PG8_MMA(1, 0, At, B0); PG8_MMA(1, 1, At, B1); PG8_BAR; PG8_SCHED;
        }
        if (wr == 0) PG8_BAR;
        E(acc, cur, wr, wc, fr, fq, tbl, ui & 1);
        if (!has_next) break;
#pragma unroll
        for (int a = 0; a < 2; ++a)
#pragma unroll
            for (int b = 0; b < 2; ++b)
#pragma unroll
                for (int m = 0; m < 4; ++m)
#pragma unroll
                    for (int n = 0; n < 2; ++n) acc[a][b][m][n] = (f32x4){0.f, 0.f, 0.f, 0.f};
        cur = nxt; cA = nA; cB = nB; ++ui;
        E.begin_unit(cur, tbl, ui & 1, tid);
        if (wr == 1) PG8_BAR;
    }
    PG8_WAIT_V(0);
    PG8_BAR;
#undef PG8_SA
#undef PG8_SB
#undef PG8_STAGE
#undef PG8_LDA
#undef PG8_LDB
#undef PG8_MMA
#undef PG8_WAIT_V
#undef PG8_WAIT_L
#undef PG8_BAR
#undef PG8_SCHED
}
}

namespace att {
#define ALAS __attribute__((address_space(3)))
using bf16x8 = __attribute__((ext_vector_type(8))) short;
using s16x4 = __attribute__((ext_vector_type(4))) short;
using f32x16 = __attribute__((ext_vector_type(16))) float;
using u32x4 = __attribute__((ext_vector_type(4))) unsigned;
typedef unsigned short bf16_t;
constexpr int SCR_OFF = 131072 + 1024, ATT_LDS = 131072;
#define ASBAR() __builtin_amdgcn_sched_barrier(0)
__device__ __forceinline__ int crow(int r, int hi) { return (r & 3) + 8 * (r >> 2) + 4 * hi; }
__device__ __forceinline__ unsigned cvtpk(float lo, float hi) { unsigned r; asm volatile("v_cvt_pk_bf16_f32 %0, %1, %2" : "=v"(r) : "v"(lo), "v"(hi)); return r; }
__device__ __forceinline__ int v_rd_base(int lane) { return ((lane & 3) << 3) | (((lane >> 2) & 3) << 6) | (((lane >> 4) & 1) << 5) | (((lane >> 5) & 1) << 8); }
constexpr int v_rd_off(int d0, int ks, int half) { return d0 * 512 + ks * 4096 + half * 2048; }
template <int OFF> __device__ __forceinline__ s16x4 tr_read(int vb) { s16x4 r; asm volatile("ds_read_b64_tr_b16 %0, %1 offset:%2" : "=&v"(r) : "v"(vb), "i"(OFF) : "memory"); return r; }

typedef short v4i16_t __attribute__((ext_vector_type(4)));
typedef float f32x2_t __attribute__((ext_vector_type(2))); typedef __bf16 bf16x2_t __attribute__((ext_vector_type(2)));
__device__ __forceinline__ unsigned cvtpk_s(float lo, float hi) { f32x2_t v = {lo, hi}; bf16x2_t b = __builtin_convertvector(v, bf16x2_t); return __builtin_bit_cast(unsigned, b); }
__device__ __forceinline__ s16x4 vtr(const ALAS char* p) { return __builtin_bit_cast(s16x4, __builtin_amdgcn_ds_read_tr16_b64_v4i16((ALAS v4i16_t*)p)); }
constexpr int KRING = 0, VRING = 65536, RSLOT = 16384;
#define AMFMA __builtin_amdgcn_mfma_f32_32x32x16_bf16
__device__ __forceinline__ bf16x8 kfrag(const ALAS char* Ks, int kb0, int i) { return *(const ALAS bf16x8*)(Ks + (kb0 ^ ((i >> 1) << 5)) + (i & 1) * 8192); }
constexpr int vfoff(int f) { return (f & 3) * 512 + (f >> 2) * 4096; }
#define VFRAG(f) (bf16x8){vlo[f][0], vlo[f][1], vlo[f][2], vlo[f][3], vhi[f][0], vhi[f][1], vhi[f][2], vhi[f][3]}

template <int I> __device__ __forceinline__ void gapA(f32x16& C0, f32x16& C1, const f32x16& P0, const f32x16& P1, const bf16x8 (&kf)[8], const bf16x8 (&qr)[4],
                                                      float& sacc, u32x4 (&pw)[4], s16x4 (&vlo)[16], s16x4 (&vhi)[16], const ALAS char* vp) {
    vlo[I] = vtr(vp + vfoff(I)); vhi[I] = vtr(vp + vfoff(I) + 2048);
    const f32x16 z = {};
    if constexpr ((I & 1) == 0) C0 = AMFMA(kf[I], qr[I >> 1], (I >> 1) == 0 ? z : C0, 0, 0, 0); else C1 = AMFMA(kf[I], qr[I >> 1], (I >> 1) == 0 ? z : C1, 0, 0, 0);
    constexpr int b = (4 * I) & 15;
    const float p0 = (I < 4) ? P0[b] : P1[b], p1 = (I < 4) ? P0[b + 1] : P1[b + 1], p2 = (I < 4) ? P0[b + 2] : P1[b + 2], p3 = (I < 4) ? P0[b + 3] : P1[b + 3];
    sacc += p0; sacc += p1; sacc += p2; sacc += p3; asm volatile("" : "+v"(sacc));
    pw[I >> 1][2 * (I & 1)] = cvtpk_s(p0, p1); pw[I >> 1][2 * (I & 1) + 1] = cvtpk_s(p2, p3); asm volatile("" : "+v"(pw[I >> 1]));
    ASBAR();
}
template <int F, bool GL> __device__ __forceinline__ void gapB(f32x16 (&o)[4], f32x16& C0, f32x16& C1, bf16x8 (&kf)[8], const u32x4 (&pw)[4], s16x4 (&vlo)[16], s16x4 (&vhi)[16],
                                                               const ALAS char* vp, const ALAS char* Kn, int kb) {
    if constexpr (F + 8 < 16) { vlo[F + 8] = vtr(vp + vfoff(F + 8)); vhi[F + 8] = vtr(vp + vfoff(F + 8) + 2048); }
    if constexpr (GL && F >= 8) kf[F - 8] = kfrag(Kn, kb, F - 8);
    o[F & 3] = AMFMA(__builtin_bit_cast(bf16x8, pw[F >> 2]), VFRAG(F), o[F & 3], 0, 0, 0);
    constexpr int e = (2 * F) & 15;
    if constexpr (F < 8) { C0[e] = __builtin_amdgcn_exp2f(C0[e]); C0[e + 1] = __builtin_amdgcn_exp2f(C0[e + 1]); asm volatile("" : "+v"(C0)); }
    else                 { C1[e] = __builtin_amdgcn_exp2f(C1[e]); C1[e + 1] = __builtin_amdgcn_exp2f(C1[e + 1]); asm volatile("" : "+v"(C1)); }
    ASBAR();
}

struct UnitMap { int mode, xcd, c, bx, G;
    __device__ __forceinline__ int count() const { return mode ? 8 : (2048 - bx + G - 1) / G; }
    __device__ __forceinline__ void get(int it, int& bh, int& qb) const { if (mode) { bh = xcd * 16 + it * 2 + (c >> 4); qb = c & 15; } else { const int u = bx + it * G; bh = u >> 4; qb = u & 15; } } };
constexpr int STG_OFF = 131072 + 2048, STG_PITCH = 272, STG_RG = 16 * STG_PITCH, ATT_LDS_TOP = STG_OFF + 4 * STG_RG;
__device__ __forceinline__ void attn_units(const UnitMap um, const bf16_t* Q, const bf16_t* K, const bf16_t* V, bf16_t* O, ALAS char* lds, float shift, float lam) {
    int tid = threadIdx.x; asm volatile("" : "+v"(tid));
    const int lane = tid & 63, r32 = lane & 31, hi = lane >> 5; const int wid = __builtin_amdgcn_readfirstlane(tid >> 6);
    const int mp = wid & 1, rg = wid >> 1;
#define KDMA_(KH, t) do { int ln_ = lane; asm volatile("" : "+v"(ln_)); _Pragma("unroll") for (int _i = 0; _i < 2; ++_i) \
        __builtin_amdgcn_global_load_lds((const unsigned*)((const char*)(KH) + (size_t)(t) * 16384 + (wid + 8 * _i) * 1024 + ln_ * 16), (ALAS unsigned*)(lds + KRING + ((t) & 3) * RSLOT + (wid + 8 * _i) * 1024), 16, 0, 0); } while (0)
#define VDMA_(VH, t) do { int ln_ = lane; asm volatile("" : "+v"(ln_)); _Pragma("unroll") for (int _i = 0; _i < 2; ++_i) \
        __builtin_amdgcn_global_load_lds((const unsigned*)((const char*)(VH) + (size_t)(t) * 16384 + (wid + 8 * _i) * 1024 + ln_ * 16), (ALAS unsigned*)(lds + VRING + ((t) & 3) * RSLOT + (wid + 8 * _i) * 1024), 16, 0, 0); } while (0)
#define KDMA(t) KDMA_(Kh, t)
#define VDMA(t) VDMA_(Vh, t)
    constexpr int NT = SEQ / 64;
    const int kb = r32 * 256 + ((mp * 128 + hi * 16) ^ ((r32 & 15) << 4));
    const ALAS char* vbase = lds + VRING + v_rd_base(lane);
    const int nu = um.count();
    int bh, qb; um.get(0, bh, qb);
    bf16x8 qr[4];
    {
        const size_t rowbase = (size_t)(bh >> 3) * SEQ;
        const bf16_t* Kh = K + (size_t)bh * 262144; const bf16_t* Vh = V + (size_t)bh * 262144;
        KDMA(0); KDMA(1); KDMA(2); KDMA(3);
        const bf16_t* Qw = Q + (rowbase + qb * 128 + rg * 32 + r32) * D_MODEL + (bh & 7) * 128 + mp * 64 + hi * 8;
#pragma unroll
        for (int d0 = 0; d0 < 4; ++d0) qr[d0] = *(const bf16x8*)(Qw + d0 * 16);
        asm volatile("" ::: "memory");
        VDMA(0); VDMA(1);
    }
    for (int it = 0; it < nu; ++it) {
    const int b = bh >> 3, h = bh & 7;
    const size_t rowbase = (size_t)b * SEQ; const int q0 = qb * 128;
    const bf16_t* Kh = K + (size_t)bh * 262144; const bf16_t* Vh = V + (size_t)bh * 262144;
    f32x16 o[4];
#pragma unroll
    for (int d = 0; d < 4; ++d) o[d] = f32x16{};
    float l = 0.f;
    bf16x8 kf[8]; u32x4 pw[4]; s16x4 vlo[16], vhi[16];
    f32x16 sA0, sA1, sB0, sB1;
    asm volatile("s_waitcnt vmcnt(4)" ::: "memory");
    __builtin_amdgcn_s_barrier(); asm volatile("" ::: "memory");
    {
#pragma unroll
        for (int i = 0; i < 8; ++i) kf[i] = kfrag(lds + KRING, kb, i);
        const f32x16 z = {};
#pragma unroll
        for (int i = 0; i < 8; ++i) { if ((i & 1) == 0) sA0 = AMFMA(kf[i], qr[i >> 1], (i >> 1) == 0 ? z : sA0, 0, 0, 0); else sA1 = AMFMA(kf[i], qr[i >> 1], (i >> 1) == 0 ? z : sA1, 0, 0, 0); }
        if (shift > 0.f) {
#pragma unroll
            for (int r = 0; r < 16; ++r) { sA0[r] -= shift; sA1[r] -= shift; } }
#pragma unroll
        for (int r = 0; r < 16; ++r) { sA0[r] = __builtin_amdgcn_exp2f(sA0[r]); sA1[r] = __builtin_amdgcn_exp2f(sA1[r]); }
#pragma unroll
        for (int i = 0; i < 8; ++i) kf[i] = kfrag(lds + KRING + RSLOT, kb, i);
    }
#define ATOP() do { asm volatile("s_waitcnt vmcnt(0)" ::: "memory"); __builtin_amdgcn_s_barrier(); asm volatile("" ::: "memory"); ASBAR(); } while (0)
#define ASTEP(C0, C1, P0, P1, t, GL, ISSUE) do { \
        const ALAS char* vp_ = vbase + (((t) - 1) & 3) * RSLOT; const ALAS char* kn_ = lds + KRING + (((t) + 1) & 3) * RSLOT; float sacc = 0.f; \
        gapA<0>(C0, C1, P0, P1, kf, qr, sacc, pw, vlo, vhi, vp_); gapA<1>(C0, C1, P0, P1, kf, qr, sacc, pw, vlo, vhi, vp_); \
        gapA<2>(C0, C1, P0, P1, kf, qr, sacc, pw, vlo, vhi, vp_); gapA<3>(C0, C1, P0, P1, kf, qr, sacc, pw, vlo, vhi, vp_); \
        gapA<4>(C0, C1, P0, P1, kf, qr, sacc, pw, vlo, vhi, vp_); gapA<5>(C0, C1, P0, P1, kf, qr, sacc, pw, vlo, vhi, vp_); \
        gapA<6>(C0, C1, P0, P1, kf, qr, sacc, pw, vlo, vhi, vp_); gapA<7>(C0, C1, P0, P1, kf, qr, sacc, pw, vlo, vhi, vp_); \
        l += sacc; \
        if (shift > 0.f) { _Pragma("unroll") for (int r = 0; r < 16; ++r) { C0[r] -= shift; C1[r] -= shift; } } \
        ASBAR(); \
        if (ISSUE) { if ((t) + 1 < NT) VDMA((t) + 1); if ((t) + 2 < NT) VDMA((t) + 2); if ((t) + 3 < NT) KDMA((t) + 3); if ((t) + 4 < NT) KDMA((t) + 4); } \
        ASBAR(); \
        gapB<0, GL>(o, C0, C1, kf, pw, vlo, vhi, vp_, kn_, kb); gapB<1, GL>(o, C0, C1, kf, pw, vlo, vhi, vp_, kn_, kb); gapB<2, GL>(o, C0, C1, kf, pw, vlo, vhi, vp_, kn_, kb); gapB<3, GL>(o, C0, C1, kf, pw, vlo, vhi, vp_, kn_, kb); \
        gapB<4, GL>(o, C0, C1, kf, pw, vlo, vhi, vp_, kn_, kb); gapB<5, GL>(o, C0, C1, kf, pw, vlo, vhi, vp_, kn_, kb); gapB<6, GL>(o, C0, C1, kf, pw, vlo, vhi, vp_, kn_, kb); gapB<7, GL>(o, C0, C1, kf, pw, vlo, vhi, vp_, kn_, kb); \
        gapB<8, GL>(o, C0, C1, kf, pw, vlo, vhi, vp_, kn_, kb); gapB<9, GL>(o, C0, C1, kf, pw, vlo, vhi, vp_, kn_, kb); gapB<10, GL>(o, C0, C1, kf, pw, vlo, vhi, vp_, kn_, kb); gapB<11, GL>(o, C0, C1, kf, pw, vlo, vhi, vp_, kn_, kb); \
        gapB<12, GL>(o, C0, C1, kf, pw, vlo, vhi, vp_, kn_, kb); gapB<13, GL>(o, C0, C1, kf, pw, vlo, vhi, vp_, kn_, kb); gapB<14, GL>(o, C0, C1, kf, pw, vlo, vhi, vp_, kn_, kb); gapB<15, GL>(o, C0, C1, kf, pw, vlo, vhi, vp_, kn_, kb); \
    } while (0)
    for (int t = 1; t + 1 < NT; t += 2) { ATOP(); ASTEP(sB0, sB1, sA0, sA1, t, true, true); ASTEP(sA0, sA1, sB0, sB1, t + 1, true, false); }
    ATOP(); ASTEP(sB0, sB1, sA0, sA1, NT - 1, false, false);
#undef ASTEP
#undef ATOP
    {
        float sacc = 0.f;
#pragma unroll
        for (int r = 0; r < 16; ++r) sacc += sB0[r] + sB1[r];
        l += sacc;
#pragma unroll
        for (int ks = 0; ks < 4; ++ks)
#pragma unroll
            for (int e = 0; e < 4; ++e) { const int b0 = (8 * ks + 2 * e) & 15; pw[ks][e] = (ks < 2) ? cvtpk_s(sB0[b0], sB0[b0 + 1]) : cvtpk_s(sB1[b0], sB1[b0 + 1]); }
        const ALAS char* vp_ = vbase + ((NT - 1) & 3) * RSLOT;
#pragma unroll
        for (int f = 0; f < 16; ++f) { vlo[f] = vtr(vp_ + vfoff(f)); vhi[f] = vtr(vp_ + vfoff(f) + 2048); o[f & 3] = AMFMA(__builtin_bit_cast(bf16x8, pw[f >> 2]), VFRAG(f), o[f & 3], 0, 0, 0); }
    }
    { auto rr = __builtin_amdgcn_permlane32_swap(__float_as_uint(l), __float_as_uint(l), false, false); l = __uint_as_float(rr[0]) + __uint_as_float(rr[1]); }
    ALAS float* scr = (ALAS float*)(lds + SCR_OFF) + wid * 32;
    if (hi == 0) scr[r32] = (mp == 0 ? 1.0f : lam) / l;
    asm volatile("s_waitcnt lgkmcnt(0)" ::: "memory");
    __builtin_amdgcn_s_barrier(); asm volatile("" ::: "memory");
    const bool has_next = it + 1 < nu;
    int nbh = bh, nqb = qb;
    if (has_next) {
        um.get(it + 1, nbh, nqb);
        const size_t nrow = (size_t)(nbh >> 3) * SEQ; const bf16_t* nKh = K + (size_t)nbh * 262144;
        KDMA_(nKh, 0); KDMA_(nKh, 1); KDMA_(nKh, 2); KDMA_(nKh, 3);
    }
    ALAS float* xch = (ALAS float*)(lds + VRING) + rg * 4096;
    if (mp == 1) {
#pragma unroll
        for (int r = 0; r < 16; ++r) { const float bb = scr[crow(r, hi)];
#pragma unroll
            for (int d = 0; d < 4; ++d) xch[(r * 4 + d) * 64 + lane] = o[d][r] * bb; }
    }
    asm volatile("s_waitcnt lgkmcnt(0)" ::: "memory");
    __builtin_amdgcn_s_barrier(); asm volatile("" ::: "memory");
    if (mp == 0) {
        ALAS char* stg = lds + STG_OFF + rg * STG_RG;
        bf16_t* Og = O + (rowbase + q0 + rg * 32) * D_MODEL + h * 128;
#pragma unroll
        for (int half = 0; half < 2; ++half) {
#pragma unroll
            for (int rr = 0; rr < 8; ++rr) {
                const int r = half * 8 + rr; const int orow = crow(r, hi); const float a = scr[orow];
                float v[4]; float ss = 0.f;
#pragma unroll
                for (int d = 0; d < 4; ++d) { v[d] = o[d][r] * a - xch[(r * 4 + d) * 64 + lane]; ss += v[d] * v[d]; }
                ss = xsum16(rowsum16(ss));
                const float rs = __builtin_amdgcn_rsqf(ss * (1.0f / 128.0f) + EPS);
                const int srow = orow - 16 * half;
#pragma unroll
                for (int d = 0; d < 4; ++d) *(ALAS unsigned short*)(stg + srow * STG_PITCH + (d * 32 + r32) * 2) = (unsigned short)(cvtpk_s(v[d] * rs, 0.f) & 0xffffu);
            }
            asm volatile("s_waitcnt lgkmcnt(0)" ::: "memory");
#pragma unroll
            for (int i = 0; i < 4; ++i) { const int srow = i * 4 + (lane >> 4), ch = lane & 15;
                const u32x4 w = *(const ALAS u32x4*)(stg + srow * STG_PITCH + ch * 16);
                *(u32x4*)(Og + (size_t)(16 * half + srow) * D_MODEL + ch * 8) = w; }
            asm volatile("s_waitcnt lgkmcnt(0)" ::: "memory");
        }
    }
    asm volatile("s_waitcnt lgkmcnt(0)" ::: "memory");
    __builtin_amdgcn_s_barrier(); asm volatile("" ::: "memory");
    if (has_next) { const size_t nrow = (size_t)(nbh >> 3) * SEQ; const bf16_t* nVh = V + (size_t)nbh * 262144;
        const bf16_t* Qw = Q + (nrow + nqb * 128 + rg * 32 + r32) * D_MODEL + (nbh & 7) * 128 + mp * 64 + hi * 8;
#pragma unroll
        for (int d0 = 0; d0 < 4; ++d0) qr[d0] = *(const bf16x8*)(Qw + d0 * 16);
        asm volatile("" ::: "memory");
        VDMA_(nVh, 0); VDMA_(nVh, 1); }
    bh = nbh; qb = nqb;
    }
    asm volatile("s_waitcnt vmcnt(0)" ::: "memory");
#undef KDMA
#undef VDMA
#undef KDMA_
#undef VDMA_
}
}

constexpr size_t MiB = 1u << 20;
constexpr size_t WS_CTL = 0, CTL_ZERO_BYTES = 64 * 1024;
constexpr size_t WS_SSQ = 406 * MiB;
constexpr size_t WS_SCAL = 2 * MiB - 4096;
constexpr size_t WS_ROPE = 2 * MiB;
constexpr size_t WS_WQKV = 4 * MiB, WS_WO = 16 * MiB, WS_WP = 20 * MiB, WS_W1 = 22 * MiB, WS_W2 = 54 * MiB;
constexpr size_t WS_XB = 86 * MiB;
constexpr size_t WS_BIG = 150 * MiB;
constexpr size_t WS_Q = WS_BIG, WS_K = WS_BIG + 64 * MiB, WS_V = WS_BIG + 128 * MiB, WS_END = WS_BIG + 256 * MiB;
constexpr size_t WS_TOTAL = WS_SSQ + 9 * (size_t)M * 64;

constexpr int RING_BYTES = 131072, MISC_OFF = RING_BYTES + 320, LDS_BYTES = 151552;
static_assert(att::ATT_LDS <= RING_BYTES && pg8::STAGE_BYTES <= RING_BYTES && att::ATT_LDS_TOP <= LDS_BYTES, "LDS map");

#define LAS __attribute__((address_space(3)))
typedef unsigned short bf16;
typedef unsigned v4u __attribute__((ext_vector_type(4)));
typedef float f32x4 __attribute__((ext_vector_type(4)));
__device__ __forceinline__ unsigned f2bf(float f) { unsigned u = __builtin_bit_cast(unsigned, f); return (u + 0x7fffu + ((u >> 16) & 1u)) >> 16; }
__device__ __forceinline__ unsigned pk2(float lo, float hi) { return f2bf(lo) | (f2bf(hi) << 16); }

#define XB_TMO      128
#define XB_XCNT(j)  (256  + 64 * (j))
#define XB_XSUB(j)  (1280 + 64 * (j))
#define XB_XGEN(j)  (2304 + 64 * (j))
#define XB_TOP      3328
#define XB_TOPGEN   3392
#define XCD_BAR_WORDS 3456
#define XB_SPIN_CAP (1u << 18)
__device__ __forceinline__ unsigned xb_ld(unsigned* p)              { return __hip_atomic_load(p, __ATOMIC_RELAXED, __HIP_MEMORY_SCOPE_AGENT); }
__device__ __forceinline__ unsigned xb_add(unsigned* p, unsigned v) { return __hip_atomic_fetch_add(p, v, __ATOMIC_RELAXED, __HIP_MEMORY_SCOPE_AGENT); }
__device__ __forceinline__ unsigned xb_xcc_id() { return (unsigned)__builtin_amdgcn_s_getreg((3 << 11) | 20) & 0xFu; }
#define XB_SPIN(cond, bar) do { unsigned _sp = 0; while (cond) { __builtin_amdgcn_s_sleep(1); \
    if ((++_sp & 255u) == 0u) { if (xb_ld(&(bar)[XB_TMO])) break; if (_sp > XB_SPIN_CAP) { atomicAdd(&(bar)[XB_TMO], 1u); break; } } } } while (0)
struct XcdBarrier { unsigned* bar; unsigned x; volatile LAS unsigned* st; };
__device__ __forceinline__ XcdBarrier xcd_barrier_post(unsigned* bar, volatile LAS unsigned* st) {
    XcdBarrier b; b.bar = bar; b.x = xb_xcc_id(); b.st = st;
    if (threadIdx.x == 0) (void)xb_add(&bar[XB_XCNT(b.x)], 1u);
    return b;
}
__device__ __forceinline__ void xcd_barrier_complete(unsigned* bar, unsigned x, unsigned& nloc, unsigned& nx) {
    const unsigned G = gridDim.x * gridDim.y * gridDim.z;
    unsigned sum, cnt, mine, sp = 0u;
    for (;;) {
        sum = 0u; cnt = 0u; mine = 0u;
#pragma unroll
        for (unsigned j = 0; j < 16; ++j) { const unsigned c = xb_ld(&bar[XB_XCNT(j)]); sum += c; cnt += (c > 0u) ? 1u : 0u; mine = (j == x) ? c : mine; }
        if (sum == G) break;
        __builtin_amdgcn_s_sleep(1);
        if ((++sp & 255u) == 0u) { if (xb_ld(&bar[XB_TMO])) break; if (sp > XB_SPIN_CAP) { atomicAdd(&bar[XB_TMO], 1u); break; } }
    }
    nloc = mine > 0u ? mine : 1u; nx = cnt > 0u ? cnt : 1u;
}
__device__ __forceinline__ void xcd_barrier(const XcdBarrier& b) {
    asm volatile("s_waitcnt vmcnt(0)" ::: "memory");
    __syncthreads();
    if (threadIdx.x == 0) {
        unsigned* bar = b.bar;
        __builtin_amdgcn_s_waitcnt(0);
        unsigned nloc = b.st[0], nx = b.st[1];
        if (nloc == 0u) { xcd_barrier_complete(bar, b.x, nloc, nx); b.st[0] = nloc; b.st[1] = nx; }
        const unsigned old = xb_add(&bar[XB_XSUB(b.x)], 1u);
        const unsigned gen = old / nloc;
        if (old + 1u == (gen + 1u) * nloc) {
            __builtin_amdgcn_fence(__ATOMIC_RELEASE, "agent");
            asm volatile("s_waitcnt vmcnt(0)" ::: "memory");
            const unsigned og = xb_add(&bar[XB_TOP], 1u);
            const unsigned tg = og / nx;
            if (og + 1u == (tg + 1u) * nx) xb_add(&bar[XB_TOPGEN], 1u);
            else XB_SPIN(xb_ld(&bar[XB_TOPGEN]) == tg, bar);
            __builtin_amdgcn_fence(__ATOMIC_ACQUIRE, "agent");
            xb_add(&bar[XB_XGEN(b.x)], 1u);
            asm volatile("s_waitcnt vmcnt(0)" ::: "memory");
        } else {
            XB_SPIN(xb_ld(&bar[XB_XGEN(b.x)]) == gen, bar);
            __builtin_amdgcn_fence(__ATOMIC_ACQUIRE, "agent");
            asm volatile("s_waitcnt vmcnt(0)" ::: "memory");
        }
    }
    __syncthreads();
}

struct Args {
    const float* x; const int* pos; const float* norm_mix; const float* norm_mlp; const float* w_qkv; const float* w_o;
    const float* q_gain; const float* k_gain; const float* lq1; const float* lk1; const float* lq2; const float* lk2; const float* sub_gain;
    const float* pool_w; const float* pool_scale; const float* w1; const float* w2;
    float* out; unsigned char* ws;
    float lam_init[2]; float inv_freq[8];
    int ph_lo, ph_hi;
};

__device__ __forceinline__ float wave_sum(float v) {
#pragma unroll
    for (int o = 1; o < 64; o <<= 1) v += __shfl_xor(v, o);
    return v;
}
struct WItem { const float* W; int K, N; bf16* WT; int row_off; const float* rsp; int rsmask; float rmul; const float* csp; int item; int mode; };
__device__ __forceinline__ void witem_load(const WItem& d, int lane, float (&v)[32]) {
    const int nblk = d.N / 32, kb = d.item / nblk, nb = d.item % nblk, k0 = 64 * kb, n0 = 32 * nb;
    const float cs = (d.csp ? d.csp[n0 + (lane & 31)] : 1.0f) * d.rmul;
#pragma unroll
    for (int i = 0; i < 32; ++i) { const int kk = 2 * i + (lane >> 5); const float rs = d.rsp ? d.rsp[(k0 + kk) & d.rsmask] : 1.0f;
        v[i] = d.W[(size_t)(k0 + kk) * d.N + n0 + (lane & 31)] * rs * cs; }
}
__device__ __forceinline__ void witem_store(const WItem& d, LAS float* scr, int lane, const float (&v)[32]) {
    const int nblk = d.N / 32, kb = d.item / nblk, nb = d.item % nblk, k0 = 64 * kb, n0 = 32 * nb;
#pragma unroll
    for (int i = 0; i < 32; ++i) scr[(2 * i + (lane >> 5)) * 33 + (lane & 31)] = v[i];
    asm volatile("s_waitcnt lgkmcnt(0)" ::: "memory");
    const int c = lane & 7;
#pragma unroll
    for (int j = 0; j < 4; ++j) { const int n = (lane >> 3) + 8 * j; const LAS float* s = scr + (8 * c) * 33 + n;
        v4u o; o.x = pk2(s[0 * 33], s[1 * 33]); o.y = pk2(s[2 * 33], s[3 * 33]); o.z = pk2(s[4 * 33], s[5 * 33]); o.w = pk2(s[6 * 33], s[7 * 33]);
        const int ng = d.row_off + n0 + n, pn = ng >> 8, nl = ng & 255, x = nl & 31, rho = 16 * ((x >> 2) & 1) + 4 * (x >> 3) + (x & 3);
        const int h = d.mode ? ((nl >> 5) & 1) : (nl >> 7), R = d.mode ? (32 * (nl >> 6) + rho) : (((nl & 127) & ~31) + rho);
        const size_t byte = (((size_t)pn * (d.K / 64) + kb) * 2 + h) * 16384 + (size_t)pg8::lds_byte(R, 8 * c);
        *(v4u*)((char*)d.WT + byte) = o; }
    asm volatile("s_waitcnt lgkmcnt(0)" ::: "memory");
}

typedef const __attribute__((address_space(4))) Args* CArgs;
__device__ __forceinline__ CArgs argp() { CArgs p = (CArgs)__builtin_amdgcn_kernarg_segment_ptr(); asm volatile("" : "+s"(p)); return p; }

__global__ void __launch_bounds__(512, 2) fwd_megakernel(Args a_) {
    extern __shared__ __attribute__((aligned(16))) unsigned char lds_raw[];
    LAS unsigned char* lds = (LAS unsigned char*)lds_raw;
    volatile LAS unsigned* MISC = (volatile LAS unsigned*)(lds + MISC_OFF);
    const int tid = threadIdx.x, lane = tid & 63, wave = __builtin_amdgcn_readfirstlane(tid >> 6);
    const int G = gridDim.x, bx = blockIdx.x, vcu0 = (G % 8 == 0) ? (bx % 8) * (G / 8) + bx / 8 : bx;
    unsigned* ctl; { const CArgs ap = argp(); ctl = (unsigned*)(ap->ws + WS_CTL); }
#define PHASE_VARS const CArgs ap = argp(); unsigned char* ws = ap->ws; float* ssq = (float*)(ws + WS_SSQ); float* scal = (float*)(ws + WS_SCAL); float* rope = (float*)(ws + WS_ROPE); \
    bf16* Wqkv_t = (bf16*)(ws + WS_WQKV); bf16* Wo_t = (bf16*)(ws + WS_WO); bf16* Wp_t = (bf16*)(ws + WS_WP); bf16* W1_t = (bf16*)(ws + WS_W1); bf16* W2_t = (bf16*)(ws + WS_W2); \
    bf16* XB = (bf16*)(ws + WS_XB); bf16* QB = (bf16*)(ws + WS_Q); bf16* KB = (bf16*)(ws + WS_K); bf16* VB = (bf16*)(ws + WS_V); bf16* HB = (bf16*)(ws + WS_BIG); bf16* DF = (bf16*)(ws + WS_BIG); \
    (void)ssq; (void)scal; (void)rope; (void)Wqkv_t; (void)Wo_t; (void)Wp_t; (void)W1_t; (void)W2_t; (void)XB; (void)QB; (void)KB; (void)VB; (void)HB; (void)DF;
#define LAYER_VARS const float* ssq_in = ssq + (size_t)(2 * i) * M * 16; float* ssq_mix = ssq + (size_t)(2 * i + 1) * M * 16; float* ssq_mlp = ssq + (size_t)(2 * i + 2) * M * 16; \
    const float* xbase = (i == 0) ? ap->x : ap->out; (void)ssq_in; (void)ssq_mix; (void)ssq_mlp; (void)xbase;
    for (int u = tid; u < (LDS_BYTES - RING_BYTES) / 4; u += 512) ((LAS unsigned*)(lds + RING_BYTES))[u] = 0u;
    __syncthreads();
    XcdBarrier bar; bar.bar = ctl + 4096; bar.x = 0; bar.st = nullptr;
#if !MK_PER_PHASE
    bar = xcd_barrier_post(ctl + 4096, MISC + 8);
#endif
    int lo, hi; { const CArgs ap = argp(); lo = ap->ph_lo; hi = ap->ph_hi; } int ph = 0;
#if !MK_PER_PHASE
    if (tid == 0) { const unsigned xcc = xb_xcc_id(); MISC[16] = xcc; MISC[17] = xb_add(ctl + 1024 + 64 * xcc, 1u); }
#endif
#if MK_PER_PHASE
#define SEAM() do { ++ph; } while (0)
#else
#define SEAM() do { if (ph == 0 && MK_CG_FIRST) { cg::this_grid().sync(); } else { xcd_barrier(bar); } ++ph; } while (0)
#endif
#define RUN (ph >= lo && ph < hi)

    if (RUN) { PHASE_VARS
        LAS float* scr = (LAS float*)(lds + wave * 16384);
        const int gw = vcu0 * 8 + wave, NGW = G * 8;
        constexpr int I_QKV = (D_MODEL / 64) * (3 * D_MODEL / 32), I_O = (D_MODEL / 64) * (D_MODEL / 32), I_1 = (D_MODEL / 64) * (FF / 32), I_2 = (FF / 64) * (D_MODEL / 32), I_P = (256 / 64) * (256 / 32);
        constexpr int NITEMS = 2 * I_QKV + 2 * I_O + 4 * I_1 + 4 * I_2 + 8 * I_P;
        auto decode = [&](int it) -> WItem {
            int r = it;
            if (r < 2 * I_QKV) { const int j = r / I_QKV; r -= j * I_QKV;
                return WItem{ap->w_qkv + (size_t)j * D_MODEL * 3 * D_MODEL, D_MODEL, 3 * D_MODEL, Wqkv_t + (size_t)j * 3 * D_MODEL * D_MODEL, 0, ap->norm_mix + (2 * j) * D_MODEL, D_MODEL - 1, 1.0f, nullptr, r, 1}; }
            r -= 2 * I_QKV;
            if (r < 2 * I_O) { const int j = r / I_O; r -= j * I_O;
                return WItem{ap->w_o + (size_t)j * D_MODEL * D_MODEL, D_MODEL, D_MODEL, Wo_t + (size_t)j * D_MODEL * D_MODEL, 0, ap->sub_gain + j * 128, 127, 1.0f - ap->lam_init[j], nullptr, r, 0}; }
            r -= 2 * I_O;
            if (r < 4 * I_1) { const int i = r / I_1; r -= i * I_1;
                return WItem{ap->w1 + (size_t)i * D_MODEL * FF, D_MODEL, FF, W1_t + (size_t)i * D_MODEL * FF, 0, ap->norm_mlp + i * D_MODEL, D_MODEL - 1, 1.0f, nullptr, r, 0}; }
            r -= 4 * I_1;
            if (r < 4 * I_2) { const int i = r / I_2; r -= i * I_2;
                return WItem{ap->w2 + (size_t)i * D_MODEL * FF, FF, D_MODEL, W2_t + (size_t)i * D_MODEL * FF, 0, nullptr, 0, 1.0f, nullptr, r, 0}; }
            r -= 4 * I_2;
            const int jg = r / I_P; r -= jg * I_P; const int j = jg >> 2, g = jg & 3;
            return WItem{ap->pool_w + (size_t)jg * 65536, 256, 256, Wp_t + (size_t)j * 1024 * 256, 256 * g, ap->norm_mix + (2 * j + 1) * D_MODEL + 256 * g, 255, 1.0f, ap->pool_scale + j * D_MODEL + 256 * g, r, 0};
        };
        {
            float va[32], vb[32];
            int it = gw;
            if (it < NITEMS) witem_load(decode(it), lane, va);
            while (it < NITEMS) {
                const int it1 = it + NGW, it2 = it + 2 * NGW;
                if (it1 < NITEMS) witem_load(decode(it1), lane, vb);
                witem_store(decode(it), scr, lane, va);
                if (it1 >= NITEMS) break;
                if (it2 < NITEMS) witem_load(decode(it2), lane, va);
                witem_store(decode(it1), scr, lane, vb);
                it = it2;
            }
        }
        float* ssq0 = ssq;
        for (int m0 = gw; m0 < M; m0 += 4 * NGW) {
            f32x4 v[4][4]; float sq[4];
#pragma unroll
            for (int q = 0; q < 4; ++q) { const int m = m0 + q * NGW; const f32x4* xr = (const f32x4*)(ap->x + (size_t)(m < M ? m : m0) * D_MODEL) + lane;
#pragma unroll
                for (int j = 0; j < 4; ++j) v[q][j] = xr[64 * j]; }
#pragma unroll
            for (int q = 0; q < 4; ++q) { float s = 0.f;
#pragma unroll
                for (int j = 0; j < 4; ++j) s += (v[q][j].x * v[q][j].x + v[q][j].y * v[q][j].y) + (v[q][j].z * v[q][j].z + v[q][j].w * v[q][j].w);
                sq[q] = wave_sum(s); }
#pragma unroll
            for (int q = 0; q < 4; ++q) { const int m = m0 + q * NGW; if (m < M) {
#pragma unroll
                for (int j = 0; j < 4; ++j) *(unsigned long long*)(XB + pg8::aimg_off(m, 4 * lane + 256 * j, D_MODEL / 64)) = (unsigned long long)pk2(v[q][j].x, v[q][j].y) | ((unsigned long long)pk2(v[q][j].z, v[q][j].w) << 32);
                if (lane < 16) ssq0[(size_t)m * 16 + lane] = (lane == 0) ? sq[q] : 0.0f;
                if (lane < 8) {
                    const float ang = (float)ap->pos[m] * ap->inv_freq[lane];
                    double rev = (double)ang * 0.15915494309189535; rev -= floor(rev);
                    const float rv = (float)rev;
                    rope[(size_t)m * 16 + lane] = __builtin_amdgcn_cosf(rv); rope[(size_t)m * 16 + 8 + lane] = __builtin_amdgcn_sinf(rv);
                } } }
        }
        if (gw == 0 && lane < 2) {
            const int j = lane; float d1 = 0.f, d2 = 0.f, mq = 0.f, mk = 0.f;
            for (int i = 0; i < 64; ++i) { d1 += ap->lq1[j * 64 + i] * ap->lk1[j * 64 + i]; d2 += ap->lq2[j * 64 + i] * ap->lk2[j * 64 + i];
                mq = fmaxf(mq, fabsf(ap->q_gain[j * 64 + i])); mk = fmaxf(mk, fabsf(ap->k_gain[j * 64 + i])); }
            scal[j] = __expf(d1) - __expf(d2) + ap->lam_init[j];
            const float bound = 8.0f * 1.4426950408889634f * mq * mk * 1.01f;
            scal[2 + j] = bound > 64.0f ? bound - 64.0f : 0.0f;
        }
    }
    SEAM();
    int vcu = vcu0, cord = bx;
#if !MK_PER_PHASE
    if (tid == 0) { const unsigned xcc = MISC[16]; unsigned base = 0u; for (unsigned jx = 0; jx < xcc; ++jx) base += xb_ld(ctl + 1024 + 64 * jx); MISC[18] = base + MISC[17]; }
    __syncthreads();
    vcu = (int)MISC[18]; if (G % 8 == 0) cord = (vcu % (G / 8)) * 8 + vcu / (G / 8);
    vcu = __builtin_amdgcn_readfirstlane(vcu); cord = __builtin_amdgcn_readfirstlane(cord);
#endif

    for (int i = 0; i < DEPTH; ++i) {
        const int j = i >> 1;
        if ((i & 1) == 0) {
            if (RUN) { PHASE_VARS LAYER_VARS
                pg8::Gemm g{XB, Wqkv_t + (size_t)j * 3 * D_MODEL * D_MODEL, M, 3 * D_MODEL, D_MODEL, D_MODEL, 0, 1}; pg8::StaticOrder S; S.init(M, 3 * D_MODEL, G, cord);
                pg8::EpiQKV E{QB, (size_t)(WS_K - WS_Q) / 2, ssq_in, rope, ap->q_gain + j * 64, ap->k_gain + j * 64, 0.125f * 1.4426950408889634f};
#ifndef SKIP_QKV
                pg8::gemm_phase<pg8::EpiQKV, pg8::StaticOrder>(lds, (LAS float*)(lds + att::STG_OFF), g, S, E);
#endif
            }
            SEAM();
            if (RUN) { PHASE_VARS
                const float lam = scal[j], shift = scal[2 + j];
                const int xcd = vcu >> 5, c = vcu & 31;
#ifndef SKIP_ATT
                { const att::UnitMap um{G == 256 ? 1 : 0, xcd, c, bx, G};
                  att::attn_units(um, QB, KB, VB, QB, (ALAS char*)lds, shift, lam); }
#endif
            }
            SEAM();
        } else {
            if (RUN) { PHASE_VARS LAYER_VARS
                LAS float* tile = (LAS float*)lds;
                for (int it = bx; it < (M / 64) * 4; it += G) {
                    const int g = ((it & 3) + (it >> 8)) & 3, t0 = (it >> 2) * 64, hw = 1 << g, s0 = t0 & (SEQ - 1), tb = t0 - s0;
                    const int rlo = (s0 - hw < 0) ? 0 : s0 - hw, rhi = (s0 + 64 + hw > SEQ) ? SEQ : s0 + 64 + hw, nrows = rhi - rlo;
                    const int col = 256 * g + 4 * lane;
                    {
                        unsigned long long xw[12]; float rsv[12];
#pragma unroll
                        for (int k = 0; k < 12; ++k) { const int r = wave + 8 * k; const int t = tb + rlo + (r < nrows ? r : 0);
                            xw[k] = *(const unsigned long long*)(XB + pg8::aimg_off(t, col, D_MODEL / 64)); rsv[k] = pg8::rstd_row(ssq_in, t); }
#pragma unroll
                        for (int k = 0; k < 12; ++k) { const int r = wave + 8 * k;
                            if (r < nrows) { f32x4 xv; xv[0] = __uint_as_float((unsigned)xw[k] << 16); xv[1] = __uint_as_float((unsigned)xw[k] & 0xffff0000u); xv[2] = __uint_as_float((unsigned)(xw[k] >> 32) << 16); xv[3] = __uint_as_float((unsigned)(xw[k] >> 32) & 0xffff0000u);
                                *(LAS f32x4*)(tile + r * 256 + 4 * lane) = xv * rsv[k]; } }
                    }
                    __syncthreads();
#pragma unroll 2
                    for (int k = 0; k < 8; ++k) {
                        const int s = s0 + wave + 8 * k;
                        const int wlo = (s - hw < 0) ? 0 : s - hw, whi = (s + hw > SEQ) ? SEQ : s + hw;
                        f32x4 acc = {0.f, 0.f, 0.f, 0.f};
                        for (int u = wlo; u < whi; ++u) acc += *(const LAS f32x4*)(tile + (u - rlo) * 256 + 4 * lane);
                        const f32x4 ctr = *(const LAS f32x4*)(tile + (s - rlo) * 256 + 4 * lane);
                        const float inv = 1.0f / (float)(whi - wlo);
                        const f32x4 d = acc * inv - ctr;
                        *(unsigned long long*)(DF + (size_t)(tb + s) * D_MODEL + col) = (unsigned long long)pk2(d.x, d.y) | ((unsigned long long)pk2(d.z, d.w) << 32);
                    }
                    __syncthreads();
                }
            }
            SEAM();
        }
        if (RUN) { PHASE_VARS LAYER_VARS
            pg8::Gemm g;
            if ((i & 1) == 0) g = pg8::Gemm{QB, Wo_t + (size_t)j * D_MODEL * D_MODEL, M, D_MODEL, D_MODEL, D_MODEL, 0, 0};
            else              g = pg8::Gemm{DF, Wp_t + (size_t)j * 1024 * 256, M, D_MODEL, 256, D_MODEL, 256, 0};
            pg8::StaticOrder S; S.init(M, D_MODEL, G, cord);
            pg8::EpiResid E{ap->out, XB, ssq_mix, D_MODEL, false, nullptr};
#ifndef SKIP_MIX
            pg8::gemm_phase<pg8::EpiResid, pg8::StaticOrder>(lds, (LAS float*)(lds + att::STG_OFF), g, S, E);
#endif
        }
        SEAM();
        if (RUN) { PHASE_VARS LAYER_VARS
            pg8::Gemm g{XB, W1_t + (size_t)i * D_MODEL * FF, M, FF, D_MODEL, D_MODEL, 0, 1}; pg8::StaticOrder S; S.init(M, FF, G, cord);
            pg8::EpiUp E{HB, FF, ssq_mix};
#ifndef SKIP_UP
            pg8::gemm_phase<pg8::EpiUp, pg8::StaticOrder>(lds, (LAS float*)(lds + att::STG_OFF), g, S, E);
#endif
        }
        SEAM();
        if (RUN) { PHASE_VARS LAYER_VARS
            pg8::Gemm g{HB, W2_t + (size_t)i * D_MODEL * FF, M, D_MODEL, FF, FF, 0, 1}; pg8::StaticOrder S; S.init(M, D_MODEL, G, cord);
            pg8::EpiResid E{ap->out, XB, ssq_mlp, D_MODEL, i == DEPTH - 1, ssq_mix};
#ifndef SKIP_DOWN
            pg8::gemm_phase<pg8::EpiResid, pg8::StaticOrder>(lds, (LAS float*)(lds + att::STG_OFF), g, S, E);
#endif
        }
        if (i < DEPTH - 1) SEAM();
    }
#undef SEAM
#undef RUN
}

constexpr int N_PHASES = 1 + 2 * 5 + 2 * 4;
extern "C" void kernel_launch(void* const* d_in, const int* in_sizes, int n_in, void* d_out, int out_size, void* d_ws, size_t ws_size, hipStream_t stream) {
    static int grid = 0;
    if (grid == 0) {
        if (n_in != 17 || in_sizes[0] != M * D_MODEL || out_size != M * D_MODEL || ws_size < WS_TOTAL) {
            fprintf(stderr, "kernel_launch: unexpected shapes: n_in %d in0 %d out %d ws %zu (need >= %zu)\n", n_in, n_in > 0 ? in_sizes[0] : -1, out_size, ws_size, (size_t)WS_TOTAL); grid = -1; return; }
        int dev = 0, cus = 0, per_cu = 0;
        if (hipGetDevice(&dev) != hipSuccess || hipDeviceGetAttribute(&cus, hipDeviceAttributeMultiprocessorCount, dev) != hipSuccess) { grid = -1; return; }
        if (hipFuncSetAttribute((const void*)fwd_megakernel, hipFuncAttributeMaxDynamicSharedMemorySize, LDS_BYTES) != hipSuccess) { fprintf(stderr, "kernel_launch: hipFuncSetAttribute failed\n"); grid = -1; return; }
        if (hipOccupancyMaxActiveBlocksPerMultiprocessor(&per_cu, (const void*)fwd_megakernel, 512, LDS_BYTES) != hipSuccess || per_cu < 1) { fprintf(stderr, "kernel_launch: occupancy query gave %d\n", per_cu); per_cu = 1; }
        (void)hipGetLastError();
        grid = cus;
    }
    if (grid < 0) return;
    (void)hipMemsetAsync((char*)d_ws + WS_CTL, 0, CTL_ZERO_BYTES, stream);
    Args a{};
    a.x = (const float*)d_in[0]; a.pos = (const int*)d_in[1]; a.norm_mix = (const float*)d_in[2]; a.norm_mlp = (const float*)d_in[3];
    a.w_qkv = (const float*)d_in[4]; a.w_o = (const float*)d_in[5]; a.q_gain = (const float*)d_in[6]; a.k_gain = (const float*)d_in[7];
    a.lq1 = (const float*)d_in[8]; a.lk1 = (const float*)d_in[9]; a.lq2 = (const float*)d_in[10]; a.lk2 = (const float*)d_in[11]; a.sub_gain = (const float*)d_in[12];
    a.pool_w = (const float*)d_in[13]; a.pool_scale = (const float*)d_in[14]; a.w1 = (const float*)d_in[15]; a.w2 = (const float*)d_in[16];
    a.out = (float*)d_out; a.ws = (unsigned char*)d_ws;
    a.lam_init[0] = (float)(0.8 - 0.6 * exp(-0.3 * 0.0)); a.lam_init[1] = (float)(0.8 - 0.6 * exp(-0.3 * 2.0));
    for (int i = 0; i < 8; ++i) a.inv_freq[i] = powf(500000.0f, -(float)(2 * i) / 16.0f);
#if MK_PER_PHASE
    for (int p = 0; p < N_PHASES; ++p) { a.ph_lo = p; a.ph_hi = p + 1; hipLaunchKernelGGL(fwd_megakernel, dim3(grid), dim3(512), LDS_BYTES, stream, a); }
#else
    a.ph_lo = 0; a.ph_hi = 1 << 30;
    void* args[] = {&a};
    const hipError_t e = hipLaunchCooperativeKernel((const void*)fwd_megakernel, dim3(grid), dim3(512), args, LDS_BYTES, stream);
    if (e != hipSuccess) fprintf(stderr, "kernel_launch: cooperative launch failed: %s (grid %d)\n", hipGetErrorString(e), grid);
#endif
}
```

```cpp
#include <hip/hip_runtime.h>
#include <hip/hip_cooperative_groups.h>
#include <cstdio>
#include <cstdint>
#include <cmath>
namespace cg = cooperative_groups;

#ifndef MK_PER_PHASE
#define MK_PER_PHASE 0
#endif
#ifndef MK_CG_FIRST
#define MK_CG_FIRST 1
#endif

constexpr int D_MODEL = 1024, BATCH = 16, SEQ = 2048, DEPTH = 4, NH = 8, FF = 4096;
constexpr int M = BATCH * SEQ;
constexpr float EPS = 1e-6f;

__device__ __forceinline__ float xsum16(float v) {
    auto r = __builtin_amdgcn_permlane16_swap(__float_as_uint(v), __float_as_uint(v), false, false); return __uint_as_float(r[0]) + __uint_as_float(r[1]); }
__device__ __forceinline__ float xsum32(float v) {
    auto r = __builtin_amdgcn_permlane32_swap(__float_as_uint(v), __float_as_uint(v), false, false); return __uint_as_float(r[0]) + __uint_as_float(r[1]); }
__device__ __forceinline__ float xget16(float v, int lane) {
    auto r = __builtin_amdgcn_permlane16_swap(__float_as_uint(v), __float_as_uint(v), false, false); return __uint_as_float(((lane >> 4) & 1) ? r[0] : r[1]); }
__device__ __forceinline__ float rowsum16(float v) {
    v += __builtin_bit_cast(float, __builtin_amdgcn_update_dpp(0, __builtin_bit_cast(int, v), 0xB1, 0xF, 0xF, true));
    v += __builtin_bit_cast(float, __builtin_amdgcn_update_dpp(0, __builtin_bit_cast(int, v), 0x4E, 0xF, 0xF, true));
    v += __builtin_bit_cast(float, __builtin_amdgcn_update_dpp(0, __builtin_bit_cast(int, v), 0x141, 0xF, 0xF, true));
    v += __builtin_bit_cast(float, __builtin_amdgcn_update_dpp(0, __builtin_bit_cast(int, v), 0x140, 0xF, 0xF, true));
    return v; }

namespace pg8 {
#define PG8_LAS __attribute__((address_space(3)))
typedef unsigned short bf16_t;
typedef short bf16x8 __attribute__((ext_vector_type(8)));
typedef float f32x4 __attribute__((ext_vector_type(4)));
typedef unsigned u32x4 __attribute__((ext_vector_type(4)));
constexpr int BM = 256, BK = 64, HALF = 128, HTB = HALF * BK * 2, STAGE_BYTES = 8 * HTB, NXCD = 8, WGM = 8;

__host__ __device__ __forceinline__ int lds_byte(int r, int c) { const int st = (r >> 4) * 2 + (c >> 5), rr = r & 15, cc = c & 31, ob = rr * 64 + cc * 2; return st * 1024 + (ob ^ (((ob >> 9) & 1) << 5)); }
__host__ __device__ __forceinline__ void stage_rc(int b, int& R, int& C) { const int st = b / 1024, sb = b % 1024, swz = sb ^ (((sb >> 9) & 1) << 5); R = (st >> 1) * 16 + swz / 64; C = (st & 1) * 32 + (swz % 64) / 2; }
__host__ __device__ __forceinline__ int perm32(int rho) { const int n = rho >> 4, i = rho & 15; return 8 * (i >> 2) + 4 * n + (i & 3); }

struct Unit { int pm, pn; };
__host__ __device__ __forceinline__ size_t aimg_off(int row, int col, int nkt) { const int rl = row & 255;
    return ((((size_t)(row >> 8) * nkt + (col >> 6)) * 2 + (rl >> 7)) * 16384 + (size_t)lds_byte(rl & 127, col & 63)) >> 1; }
struct Gemm { const bf16_t* A; const bf16_t* Bt; int M, N, K, lda, apn, aimg; };

struct StaticOrder {
    int nM, nN, nwg, G, c;
    __host__ __device__ void init(int M_, int N_, int G_, int c_) { nM = M_ / BM; nN = N_ / BM; nwg = nM * nN; G = G_; c = c_; }
    __host__ __device__ bool next(int i, Unit& u) const {
        const long L = (long)i * G + c; if (L >= nwg) return false;
        int wgid = (int)L; { const int q = nwg / NXCD, r = nwg % NXCD, xcd = wgid % NXCD, off = wgid / NXCD; wgid = (xcd < r ? xcd * (q + 1) : r * (q + 1) + (xcd - r) * q) + off; }
        const int nig = WGM * nN, gid = wgid / nig, fm = gid * WGM, gsz = (nM - fm) < WGM ? (nM - fm) : WGM;
        u.pm = fm + ((wgid % nig) % gsz); u.pn = (wgid % nig) / gsz; return true;
    }
};

__device__ __forceinline__ unsigned cvt_pk_bf16(float lo, float hi) { unsigned r; asm volatile("v_cvt_pk_bf16_f32 %0, %1, %2" : "=v"(r) : "v"(lo), "v"(hi)); return r; }
__device__ __forceinline__ float rstd_row(const float* part, int row) {
    const f32x4* p = (const f32x4*)(part + (size_t)row * 16); const f32x4 a = p[0], b = p[1], c = p[2], d = p[3];
    const float s = (((a[0] + a[1]) + (a[2] + a[3])) + ((b[0] + b[1]) + (b[2] + b[3]))) + (((c[0] + c[1]) + (c[2] + c[3])) + ((d[0] + d[1]) + (d[2] + d[3])));
    return __builtin_amdgcn_rsqf(s * (1.0f / D_MODEL) + EPS);
}


struct EpiResid {
    static constexpr bool PERM = true, HEADPERM = false;
    float* out; bf16_t* xb; float* ssq; int ldc; bool last; const float* rs2src;
    __device__ __forceinline__ void begin_unit(const Unit& u, PG8_LAS float* t0, int par, int tid) const { if (rs2src && tid < 256) { const float r = rstd_row(rs2src, u.pm * BM + tid); t0[par * 256 + tid] = r * r; } }
    __device__ __forceinline__ void operator()(const f32x4 (&acc)[2][2][4][2], const Unit& u, int wr, int wc, int fr, int fq, const PG8_LAS float* t0, int par) const {
        const PG8_LAS float* tb = t0 + par * 256;
        const int row0 = u.pm * BM + wr * 64 + fr, col0 = u.pn * BM + wc * 32 + 8 * fq;
#pragma unroll
        for (int ai = 0; ai < 2; ++ai) {
            u32x4 xin[4][2];
#pragma unroll
            for (int m = 0; m < 4; ++m)
#pragma unroll
                for (int bj = 0; bj < 2; ++bj) xin[m][bj] = *(const u32x4*)(xb + aimg_off(row0 + ai * HALF + m * 16, col0 + bj * HALF, ldc / 64));
            asm volatile("" ::: "memory");
#pragma unroll
            for (int m = 0; m < 4; ++m) {
                const int row = row0 + ai * HALF + m * 16; float ss = 0.f; const float r2 = rs2src ? tb[row - u.pm * BM] : 1.0f;
#pragma unroll
                for (int bj = 0; bj < 2; ++bj) {
                    const size_t off = (size_t)row * ldc + col0 + bj * HALF, offx = aimg_off(row, col0 + bj * HALF, ldc / 64);
                    const u32x4 xw = xin[m][bj];
                    f32x4 b0, b1;
                    b0[0] = __uint_as_float(xw.x << 16); b0[1] = __uint_as_float(xw.x & 0xffff0000u); b0[2] = __uint_as_float(xw.y << 16); b0[3] = __uint_as_float(xw.y & 0xffff0000u);
                    b1[0] = __uint_as_float(xw.z << 16); b1[1] = __uint_as_float(xw.z & 0xffff0000u); b1[2] = __uint_as_float(xw.w << 16); b1[3] = __uint_as_float(xw.w & 0xffff0000u);
                    const f32x4 v0 = acc[ai][bj][m][0] * r2 + b0, v1 = acc[ai][bj][m][1] * r2 + b1;
                    if (last) { *(f32x4*)(out + off) = v0; *(f32x4*)(out + off + 4) = v1; }
                    else {
                        ss += (v0[0] * v0[0] + v0[1] * v0[1]) + (v0[2] * v0[2] + v0[3] * v0[3]) + (v1[0] * v1[0] + v1[1] * v1[1]) + (v1[2] * v1[2] + v1[3] * v1[3]);
                        u32x4 w; w.x = cvt_pk_bf16(v0[0], v0[1]); w.y = cvt_pk_bf16(v0[2], v0[3]); w.z = cvt_pk_bf16(v1[0], v1[1]); w.w = cvt_pk_bf16(v1[2], v1[3]); *(u32x4*)(xb + offx) = w;
                    }
                }
                if (!last) { ss = xsum16(ss); ss = xsum32(ss); if (fq == 0) ssq[(size_t)row * 16 + u.pn * 4 + wc] = ss; }
            }
        }
    }
};
struct EpiUp {
    static constexpr bool PERM = true, HEADPERM = false;
    bf16_t* H; int ldc; const float* ssq;
    __device__ __forceinline__ void begin_unit(const Unit&, PG8_LAS float*, int, int) const {}
    __device__ __forceinline__ void operator()(const f32x4 (&acc)[2][2][4][2], const Unit& u, int wr, int wc, int fr, int fq, const PG8_LAS float*, int) const {
        const int row0 = u.pm * BM + wr * 64 + fr, col0 = u.pn * BM + wc * 32 + 8 * fq;
#pragma unroll
        for (int ai = 0; ai < 2; ++ai)
#pragma unroll
            for (int m = 0; m < 4; ++m) {
                const int row = row0 + ai * HALF + m * 16;
#pragma unroll
                for (int bj = 0; bj < 2; ++bj) {
                    f32x4 v0 = acc[ai][bj][m][0], v1 = acc[ai][bj][m][1];
#pragma unroll
                    for (int j = 0; j < 4; ++j) { const float a = fmaxf(v0[j], 0.f), b = fmaxf(v1[j], 0.f); v0[j] = a * a; v1[j] = b * b; }
                    u32x4 w; w.x = cvt_pk_bf16(v0[0], v0[1]); w.y = cvt_pk_bf16(v0[2], v0[3]); w.z = cvt_pk_bf16(v1[0], v1[1]); w.w = cvt_pk_bf16(v1[2], v1[3]);
                    *(u32x4*)(H + aimg_off(row, col0 + bj * HALF, ldc / 64)) = w;
                }
            }
    }
};
struct EpiQKV {
    static constexpr bool PERM = true, HEADPERM = true;
    bf16_t* Q; size_t tstride; const float* ssq; const float* rope; const float* qg; const float* kg; float qscale;
    __device__ __forceinline__ void begin_unit(const Unit& u, PG8_LAS float* t0, int par, int tid) const {
        if (tid < 256) { const int row = u.pm * BM + tid; t0[par * 256 + tid] = rstd_row(ssq, row);
            if ((u.pn >> 2) < 2) { const f32x4* rp = (const f32x4*)(rope + (size_t)row * 16); const f32x4 a = rp[0], b = rp[1], c = rp[2], d = rp[3];
                typedef __fp16 h2 __attribute__((ext_vector_type(2)));
                u32x4 w0, w1;
                w0.x = __builtin_bit_cast(unsigned, __builtin_amdgcn_cvt_pkrtz(a[0], a[1])); w0.y = __builtin_bit_cast(unsigned, __builtin_amdgcn_cvt_pkrtz(a[2], a[3]));
                w0.z = __builtin_bit_cast(unsigned, __builtin_amdgcn_cvt_pkrtz(b[0], b[1])); w0.w = __builtin_bit_cast(unsigned, __builtin_amdgcn_cvt_pkrtz(b[2], b[3]));
                w1.x = __builtin_bit_cast(unsigned, __builtin_amdgcn_cvt_pkrtz(c[0], c[1])); w1.y = __builtin_bit_cast(unsigned, __builtin_amdgcn_cvt_pkrtz(c[2], c[3]));
                w1.z = __builtin_bit_cast(unsigned, __builtin_amdgcn_cvt_pkrtz(d[0], d[1])); w1.w = __builtin_bit_cast(unsigned, __builtin_amdgcn_cvt_pkrtz(d[2], d[3]));
                PG8_LAS u32x4* dst = (PG8_LAS u32x4*)((PG8_LAS char*)t0 + 2048 + par * 8192 + tid * 32); dst[0] = w0; dst[1] = w1; } }
    }
    __device__ __forceinline__ void operator()(const f32x4 (&acc)[2][2][4][2], const Unit& u, int wr, int wc, int fr, int fq, const PG8_LAS float* t0, int par) const {
        const PG8_LAS float* tb = t0 + par * 256; const PG8_LAS char* rtab = (const PG8_LAS char*)t0 + 2048 + par * 8192;
        const int type = u.pn >> 2;
        bf16_t* dst = Q + (size_t)type * tstride;
        const int colw = (u.pn & 3) * 256 + wc * 64 + 8 * fq;
        const int row0 = u.pm * BM + wr * 64 + fr;
        if (type == 2) {
#pragma unroll
            for (int ai = 0; ai < 2; ++ai)
#pragma unroll
                for (int m = 0; m < 4; ++m) {
                    const int row = row0 + ai * HALF + m * 16; const float rstd = tb[row - u.pm * BM];
#pragma unroll
                    for (int bj = 0; bj < 2; ++bj) {
                        const f32x4 v0 = acc[ai][bj][m][0] * rstd, v1 = acc[ai][bj][m][1] * rstd;
                        u32x4 w; w.x = cvt_pk_bf16(v0[0], v0[1]); w.y = cvt_pk_bf16(v0[2], v0[3]); w.z = cvt_pk_bf16(v1[0], v1[1]); w.w = cvt_pk_bf16(v1[2], v1[3]);
                        { const int col = colw + 32 * bj, hd = col >> 7, dh = col & 127, key = row & (SEQ - 1), kk = key & 63;
                          const size_t byte = ((size_t)(((row >> 11) * 8 + hd) * 32 + (key >> 6)) << 14) + (size_t)(((kk >> 3) * 4 + (dh >> 5)) * 512 + ((kk & 7) * 32 + (dh & 31)) * 2);
                          *(u32x4*)((char*)dst + byte) = w; }
                    }
                }
        } else {
            const float* gp = type == 0 ? qg : kg; const float gs = type == 0 ? qscale : 1.0f;
            f32x4 gv[2][2];
#pragma unroll
            for (int bj = 0; bj < 2; ++bj)
#pragma unroll
                for (int n = 0; n < 2; ++n) gv[bj][n] = *(const f32x4*)(gp + 32 * bj + 8 * fq + 4 * n) * gs;
#pragma unroll
            for (int ai = 0; ai < 2; ++ai)
#pragma unroll
                for (int m = 0; m < 4; ++m) {
                    const int row = row0 + ai * HALF + m * 16; const float rstd = tb[row - u.pm * BM];
                    f32x4 t[2][2]; float ss = 0.f;
#pragma unroll
                    for (int bj = 0; bj < 2; ++bj)
#pragma unroll
                        for (int n = 0; n < 2; ++n) { const f32x4 x = acc[ai][bj][m][n]; ss += (x[0] * x[0] + x[1] * x[1]) + (x[2] * x[2] + x[3] * x[3]); }
                    ss = xsum16(ss); ss = xsum32(ss);
                    const float sc = rstd * __builtin_amdgcn_rsqf(rstd * rstd * ss * (1.0f / 64.0f) + EPS);
#pragma unroll
                    for (int bj = 0; bj < 2; ++bj)
#pragma unroll
                        for (int n = 0; n < 2; ++n) t[bj][n] = acc[ai][bj][m][n] * (gv[bj][n] * sc);
                    const PG8_LAS char* rp = rtab + (row - u.pm * BM) * 32;
#pragma unroll
                    for (int n = 0; n < 2; ++n) {
                        f32x4 p;
#pragma unroll
                        for (int j = 0; j < 4; ++j) p[j] = xget16(t[0][n][j], fq << 4);
                        if (fq < 2) {
                            typedef __fp16 h4 __attribute__((ext_vector_type(4)));
                            const h4 ch = *(const PG8_LAS h4*)(rp + 8 * n), sh = *(const PG8_LAS h4*)(rp + 16 + 8 * n);
                            const f32x4 cs = {(float)ch[0], (float)ch[1], (float)ch[2], (float)ch[3]}, sn = {(float)sh[0], (float)sh[1], (float)sh[2], (float)sh[3]};
                            t[0][n] = (fq == 0) ? (t[0][n] * cs - p * sn) : (t[0][n] * cs + p * sn);
                        }
                    }
#pragma unroll
                    for (int bj = 0; bj < 2; ++bj) {
                        const f32x4 v0 = t[bj][0], v1 = t[bj][1];
                        u32x4 w; w.x = cvt_pk_bf16(v0[0], v0[1]); w.y = cvt_pk_bf16(v0[2], v0[3]); w.z = cvt_pk_bf16(v1[0], v1[1]); w.w = cvt_pk_bf16(v1[2], v1[3]);
                        if (type == 0) *(u32x4*)(dst + (size_t)row * D_MODEL + colw + 32 * bj) = w;
                        else { const int col = colw + 32 * bj, hd = col >> 7, dh = col & 127, key = row & (SEQ - 1), kk = key & 63;
                          const size_t byte = ((size_t)(((row >> 11) * 8 + hd) * 32 + (key >> 6)) << 14) + (size_t)(kk * 256 + ((dh * 2) ^ ((kk & 15) << 4)));
                          *(u32x4*)((char*)dst + byte) = w; }
                    }
                }
        }
    }
};

template <class Epi, class Sched>
__device__ __forceinline__ void gemm_phase(PG8_LAS unsigned char* lds, PG8_LAS float* tbl, const Gemm g, const Sched& S, const Epi& E) {
    int tid = threadIdx.x; asm volatile("" : "+v"(tid));
    const int wid = __builtin_amdgcn_readfirstlane(tid >> 6), lane = tid & 63, wr = wid >> 2, wc = wid & 3, fr = lane & 15, fq = lane >> 4;
    const int K = g.K, nt = K / BK, lda = g.lda;
    unsigned voffA[2], voffB[2];
#pragma unroll
    for (int i = 0; i < 2; ++i) { int R, C; stage_rc(tid * 16 + i * 8192, R, C);
        const int Rb = Epi::HEADPERM ? (64 * (R >> 5) + perm32(R & 31)) : (Epi::PERM ? ((R & ~31) + perm32(R & 31)) : R);
        voffA[i] = g.aimg ? (unsigned)(tid * 16 + i * 8192) : (unsigned)(R * lda + C) * 2u; (void)Rb; voffB[i] = (unsigned)(tid * 16 + i * 8192); }
    const size_t kstep = g.aimg ? 2 * (size_t)HTB : (size_t)(BK * 2);
    const size_t hstepA = g.aimg ? (size_t)HTB : (size_t)HALF * lda * 2, tstepA = g.aimg ? (size_t)(lda / 64) * 2 * HTB : 2 * (size_t)HALF * lda * 2;
    const size_t hstepB = (size_t)HTB, kstepB = 2 * (size_t)HTB, tstepB = (size_t)BM * K * 2;
    const unsigned ldsw = (unsigned)wid * 1024u;
    const int aoff = lds_byte(wr * 64 + fr, fq * 8), boff = lds_byte(wc * 32 + fr, fq * 8);
#define PG8_SA(b, h) (((b) * 2 + (h)) * HTB)
#define PG8_SB(b, h) ((4 + (b) * 2 + (h)) * HTB)
#define PG8_STAGE(bufoff, gbase, voff) do { _Pragma("unroll") for (int _i = 0; _i < 2; ++_i) \
        __builtin_amdgcn_global_load_lds((const unsigned*)((const char*)(gbase) + (voff)[_i]), (PG8_LAS unsigned*)(lds + (bufoff) + ldsw + _i * 8192), 16, 0, 0); } while (0)
#define PG8_LDA(dst, b, h) do { _Pragma("unroll") for (int m = 0; m < 4; ++m) _Pragma("unroll") for (int k = 0; k < 2; ++k) dst[m][k] = *(const PG8_LAS bf16x8*)(lds + PG8_SA(b, h) + aoff + m * 2048 + k * 1024); } while (0)
#define PG8_LDB(dst, b, h) do { _Pragma("unroll") for (int n = 0; n < 2; ++n) _Pragma("unroll") for (int k = 0; k < 2; ++k) dst[n][k] = *(const PG8_LAS bf16x8*)(lds + PG8_SB(b, h) + boff + n * 2048 + k * 1024); } while (0)
#define PG8_MMA(ai, bj, At, Bt) do { __builtin_amdgcn_s_setprio(1); _Pragma("unroll") for (int m = 0; m < 4; ++m) _Pragma("unroll") for (int n = 0; n < 2; ++n) _Pragma("unroll") for (int k = 0; k < 2; ++k) \
        acc[ai][bj][m][n] = __builtin_amdgcn_mfma_f32_16x16x32_bf16(Bt[n][k], At[m][k], acc[ai][bj][m][n], 0, 0, 0); __builtin_amdgcn_s_setprio(0); } while (0)
#define PG8_WAIT_V(n) asm volatile("s_waitcnt vmcnt(" #n ")" ::: "memory")
#define PG8_WAIT_L(n) asm volatile("s_waitcnt lgkmcnt(" #n ")" ::: "memory")
#define PG8_BAR __builtin_amdgcn_s_barrier()
#define PG8_SCHED __builtin_amdgcn_sched_barrier(0)
    Unit cur, nxt; int ui = 0;
    if (!S.next(0, cur)) return;
    f32x4 acc[2][2][4][2];
#pragma unroll
    for (int a = 0; a < 2; ++a)
#pragma unroll
        for (int b = 0; b < 2; ++b)
#pragma unroll
            for (int m = 0; m < 4; ++m)
#pragma unroll
                for (int n = 0; n < 2; ++n) acc[a][b][m][n] = (f32x4){0.f, 0.f, 0.f, 0.f};
    bf16x8 At[4][2], B0[2][2], B1[2][2];
    const char* cA = (const char*)g.A + (size_t)cur.pm * tstepA + (size_t)cur.pn * g.apn * 2; const char* cB = (const char*)g.Bt + (size_t)cur.pn * tstepB;
    E.begin_unit(cur, tbl, 0, tid);
    PG8_STAGE(PG8_SB(0, 0), cB, voffB); PG8_STAGE(PG8_SB(0, 1), cB + hstepB, voffB); PG8_STAGE(PG8_SA(0, 0), cA, voffA); PG8_STAGE(PG8_SA(0, 1), cA + hstepA, voffA);
    if (wr == 1) PG8_BAR;
    PG8_WAIT_V(2); PG8_BAR;
    PG8_STAGE(PG8_SB(1, 0), cB + kstepB, voffB); PG8_STAGE(PG8_SA(1, 0), cA + kstep, voffA); PG8_STAGE(PG8_SB(1, 1), cB + hstepB + kstepB, voffB);
    PG8_WAIT_V(6); PG8_BAR;
    for (;;) {
        const bool has_next = S.next(ui + 1, nxt);
        const char* nA = has_next ? (const char*)g.A + (size_t)nxt.pm * tstepA + (size_t)nxt.pn * g.apn * 2 : cA; const char* nB = has_next ? (const char*)g.Bt + (size_t)nxt.pn * tstepB : cB;
        for (int t = 0; t < nt; t += 2) {
            const bool last = (t == nt - 2);
            const char* a1 = cA + (size_t)(t + 1) * kstep;
            const char* a2 = last ? nA : cA + (size_t)(t + 2) * kstep; const char* b2 = last ? nB : cB + (size_t)(t + 2) * kstepB;
            const char* a3 = a2 + kstep; const char* b3 = b2 + kstepB;
            PG8_LDB(B0, 0, 0); PG8_LDB(B1, 0, 1); PG8_SCHED; PG8_LDA(At, 0, 0); PG8_STAGE(PG8_SA(1, 1), a1 + hstepA, voffA);
            PG8_WAIT_V(8); PG8_WAIT_L(0); PG8_BAR; PG8_MMA(0, 0, At, B0); PG8_MMA(0, 1, At, B1); PG8_BAR; PG8_SCHED;
            PG8_LDA(At, 0, 1); PG8_STAGE(PG8_SB(0, 0), b2, voffB); PG8_STAGE(PG8_SB(0, 1), b2 + hstepB, voffB); PG8_STAGE(PG8_SA(0, 0), a2, voffA);
            PG8_WAIT_V(8); PG8_WAIT_L(0); PG8_BAR; PG8_MMA(1, 0, At, B0); PG8_MMA(1, 1, At, B1); PG8_BAR; PG8_SCHED;
            PG8_LDB(B0, 1, 0); PG8_LDB(B1, 1, 1); PG8_SCHED; PG8_LDA(At, 1, 0); PG8_STAGE(PG8_SA(0, 1), a2 + hstepA, voffA);
            PG8_WAIT_V(8); PG8_WAIT_L(0); PG8_BAR; PG8_MMA(0, 0, At, B0); PG8_MMA(0, 1, At, B1); PG8_BAR; PG8_SCHED;
            PG8_LDA(At, 1, 1); PG8_STAGE(PG8_SB(1, 0), b3, voffB); PG8_STAGE(PG8_SB(1, 1), b3 + hstepB, voffB); PG8_STAGE(PG8_SA(1, 0), a3, voffA);
            PG8_WAIT_V(8); PG8_WAIT_L(0); PG8_BAR; PG8_MMA(1, 0, At, B0); PG8_MMA(1, 1, At, B1); PG8_BAR; PG8_SCHED;
        }
        if (wr == 0) PG8_BAR;
        E(acc, cur, wr, wc, fr, fq, tbl, ui & 1);
        if (!has_next) break;
#pragma unroll
        for (int a = 0; a < 2; ++a)
#pragma unroll
            for (int b = 0; b < 2; ++b)
#pragma unroll
                for (int m = 0; m < 4; ++m)
#pragma unroll
                    for (int n = 0; n < 2; ++n) acc[a][b][m][n] = (f32x4){0.f, 0.f, 0.f, 0.f};
        cur = nxt; cA = nA; cB = nB; ++ui;
        E.begin_unit(cur, tbl, ui & 1, tid);
        if (wr == 1) PG8_BAR;
    }
    PG8_WAIT_V(0);
    PG8_BAR;
#undef PG8_SA
#undef PG8_SB
#undef PG8_STAGE
#undef PG8_LDA
#undef PG8_LDB
#undef PG8_MMA
#undef PG8_WAIT_V
#undef PG8_WAIT_L
#undef PG8_BAR
#undef PG8_SCHED
}
}

namespace att {
#define ALAS __attribute__((address_space(3)))
using bf16x8 = __attribute__((ext_vector_type(8))) short;
using s16x4 = __attribute__((ext_vector_type(4))) short;
using f32x16 = __attribute__((ext_vector_type(16))) float;
using u32x4 = __attribute__((ext_vector_type(4))) unsigned;
typedef unsigned short bf16_t;
constexpr int SCR_OFF = 131072 + 1024, ATT_LDS = 131072;
#define ASBAR() __builtin_amdgcn_sched_barrier(0)
__device__ __forceinline__ int crow(int r, int hi) { return (r & 3) + 8 * (r >> 2) + 4 * hi; }
__device__ __forceinline__ unsigned cvtpk(float lo, float hi) { unsigned r; asm volatile("v_cvt_pk_bf16_f32 %0, %1, %2" : "=v"(r) : "v"(lo), "v"(hi)); return r; }
__device__ __forceinline__ int v_rd_base(int lane) { return ((lane & 3) << 3) | (((lane >> 2) & 3) << 6) | (((lane >> 4) & 1) << 5) | (((lane >> 5) & 1) << 8); }
constexpr int v_rd_off(int d0, int ks, int half) { return d0 * 512 + ks * 4096 + half * 2048; }
template <int OFF> __device__ __forceinline__ s16x4 tr_read(int vb) { s16x4 r; asm volatile("ds_read_b64_tr_b16 %0, %1 offset:%2" : "=&v"(r) : "v"(vb), "i"(OFF) : "memory"); return r; }

typedef short v4i16_t __attribute__((ext_vector_type(4)));
typedef float f32x2_t __attribute__((ext_vector_type(2))); typedef __bf16 bf16x2_t __attribute__((ext_vector_type(2)));
__device__ __forceinline__ unsigned cvtpk_s(float lo, float hi) { f32x2_t v = {lo, hi}; bf16x2_t b = __builtin_convertvector(v, bf16x2_t); return __builtin_bit_cast(unsigned, b); }
__device__ __forceinline__ s16x4 vtr(const ALAS char* p) { return __builtin_bit_cast(s16x4, __builtin_amdgcn_ds_read_tr16_b64_v4i16((ALAS v4i16_t*)p)); }
constexpr int KRING = 0, VRING = 65536, RSLOT = 16384;
#define AMFMA __builtin_amdgcn_mfma_f32_32x32x16_bf16
__device__ __forceinline__ bf16x8 kfrag(const ALAS char* Ks, int kb0, int i) { return *(const ALAS bf16x8*)(Ks + (kb0 ^ ((i >> 1) << 5)) + (i & 1) * 8192); }
constexpr int vfoff(int f) { return (f & 3) * 512 + (f >> 2) * 4096; }
#define VFRAG(f) (bf16x8){vlo[f][0], vlo[f][1], vlo[f][2], vlo[f][3], vhi[f][0], vhi[f][1], vhi[f][2], vhi[f][3]}

template <int I> __device__ __forceinline__ void gapA(f32x16& C0, f32x16& C1, const f32x16& P0, const f32x16& P1, const bf16x8 (&kf)[8], const bf16x8 (&qr)[4],
                                                      float& sacc, u32x4 (&pw)[4], s16x4 (&vlo)[16], s16x4 (&vhi)[16], const ALAS char* vp) {
    vlo[I] = vtr(vp + vfoff(I)); vhi[I] = vtr(vp + vfoff(I) + 2048);
    const f32x16 z = {};
    if constexpr ((I & 1) == 0) C0 = AMFMA(kf[I], qr[I >> 1], (I >> 1) == 0 ? z : C0, 0, 0, 0); else C1 = AMFMA(kf[I], qr[I >> 1], (I >> 1) == 0 ? z : C1, 0, 0, 0);
    constexpr int b = (4 * I) & 15;
    const float p0 = (I < 4) ? P0[b] : P1[b], p1 = (I < 4) ? P0[b + 1] : P1[b + 1], p2 = (I < 4) ? P0[b + 2] : P1[b + 2], p3 = (I < 4) ? P0[b + 3] : P1[b + 3];
    sacc += p0; sacc += p1; sacc += p2; sacc += p3; asm volatile("" : "+v"(sacc));
    pw[I >> 1][2 * (I & 1)] = cvtpk_s(p0, p1); pw[I >> 1][2 * (I & 1) + 1] = cvtpk_s(p2, p3); asm volatile("" : "+v"(pw[I >> 1]));
    ASBAR();
}
template <int F, bool GL> __device__ __forceinline__ void gapB(f32x16 (&o)[4], f32x16& C0, f32x16& C1, bf16x8 (&kf)[8], const u32x4 (&pw)[4], s16x4 (&vlo)[16], s16x4 (&vhi)[16],
                                                               const ALAS char* vp, const ALAS char* Kn, int kb) {
    if constexpr (F + 8 < 16) { vlo[F + 8] = vtr(vp + vfoff(F + 8)); vhi[F + 8] = vtr(vp + vfoff(F + 8) + 2048); }
    if constexpr (GL && F >= 8) kf[F - 8] = kfrag(Kn, kb, F - 8);
    o[F & 3] = AMFMA(__builtin_bit_cast(bf16x8, pw[F >> 2]), VFRAG(F), o[F & 3], 0, 0, 0);
    constexpr int e = (2 * F) & 15;
    if constexpr (F < 8) { C0[e] = __builtin_amdgcn_exp2f(C0[e]); C0[e + 1] = __builtin_amdgcn_exp2f(C0[e + 1]); asm volatile("" : "+v"(C0)); }
    else                 { C1[e] = __builtin_amdgcn_exp2f(C1[e]); C1[e + 1] = __builtin_amdgcn_exp2f(C1[e + 1]); asm volatile("" : "+v"(C1)); }
    ASBAR();
}

struct UnitMap { int mode, xcd, c, bx, G;
    __device__ __forceinline__ int count() const { return mode ? 8 : (2048 - bx + G - 1) / G; }
    __device__ __forceinline__ void get(int it, int& bh, int& qb) const { if (mode) { bh = xcd * 16 + it * 2 + (c >> 4); qb = c & 15; } else { const int u = bx + it * G; bh = u >> 4; qb = u & 15; } } };
constexpr int STG_OFF = 131072 + 2048, STG_PITCH = 272, STG_RG = 16 * STG_PITCH, ATT_LDS_TOP = STG_OFF + 4 * STG_RG;
__device__ __forceinline__ void attn_units(const UnitMap um, const bf16_t* Q, const bf16_t* K, const bf16_t* V, bf16_t* O, ALAS char* lds, float shift, float lam) {
    int tid = threadIdx.x; asm volatile("" : "+v"(tid));
    const int lane = tid & 63, r32 = lane & 31, hi = lane >> 5; const int wid = __builtin_amdgcn_readfirstlane(tid >> 6);
    const int mp = wid & 1, rg = wid >> 1;
#define AGLDS16(gsrc, ldsdst) do { unsigned keep_; asm volatile("s_mov_b32 %0, m0\n\ts_mov_b32 m0, %2\n\ts_nop 0\n\tglobal_load_lds_dwordx4 %1, off\n\ts_mov_b32 m0, %0" : "=&s"(keep_) : "v"(gsrc), "s"(ldsdst) : "memory"); } while (0)
#define KDMA_(KH, t) do { int ln_ = lane; asm volatile("" : "+v"(ln_)); _Pragma("unroll") for (int _i = 0; _i < 2; ++_i) \
        AGLDS16((const char*)(KH) + (size_t)(t) * 16384 + (wid + 8 * _i) * 1024 + ln_ * 16, (unsigned)__builtin_amdgcn_readfirstlane((int)(lds0 + KRING + ((t) & 3) * RSLOT + (wid + 8 * _i) * 1024))); } while (0)
#define VDMA_(VH, t) do { int ln_ = lane; asm volatile("" : "+v"(ln_)); _Pragma("unroll") for (int _i = 0; _i < 2; ++_i) \
        AGLDS16((const char*)(VH) + (size_t)(t) * 16384 + (wid + 8 * _i) * 1024 + ln_ * 16, (unsigned)__builtin_amdgcn_readfirstlane((int)(lds0 + VRING + ((t) & 3) * RSLOT + (wid + 8 * _i) * 1024))); } while (0)
#define KDMA(t) KDMA_(Kh, t)
#define VDMA(t) VDMA_(Vh, t)
    constexpr int NT = SEQ / 64;
    const unsigned lds0 = (unsigned)(uintptr_t)lds;
    const int kb = r32 * 256 + ((mp * 128 + hi * 16) ^ ((r32 & 15) << 4));
    const ALAS char* vbase = lds + VRING + v_rd_base(lane);
    const int nu = um.count();
    int bh, qb; um.get(0, bh, qb);
    bf16x8 qr[4];
    {
        const size_t rowbase = (size_t)(bh >> 3) * SEQ;
        const bf16_t* Kh = K + (size_t)bh * 262144; const bf16_t* Vh = V + (size_t)bh * 262144;
        KDMA(0); KDMA(1); KDMA(2); KDMA(3);
        const bf16_t* Qw = Q + (rowbase + qb * 128 + rg * 32 + r32) * D_MODEL + (bh & 7) * 128 + mp * 64 + hi * 8;
#pragma unroll
        for (int d0 = 0; d0 < 4; ++d0) qr[d0] = *(const bf16x8*)(Qw + d0 * 16);
        asm volatile("" ::: "memory");
        VDMA(0); VDMA(1);
    }
    for (int it = 0; it < nu; ++it) {
    const int b = bh >> 3, h = bh & 7;
    const size_t rowbase = (size_t)b * SEQ; const int q0 = qb * 128;
    const bf16_t* Kh = K + (size_t)bh * 262144; const bf16_t* Vh = V + (size_t)bh * 262144;
    f32x16 o[4];
#pragma unroll
    for (int d = 0; d < 4; ++d) o[d] = f32x16{};
    float l = 0.f;
    bf16x8 kf[8]; u32x4 pw[4]; s16x4 vlo[16], vhi[16];
    f32x16 sA0, sA1, sB0, sB1;
    asm volatile("s_waitcnt vmcnt(4)" ::: "memory");
    __builtin_amdgcn_s_barrier(); asm volatile("" ::: "memory");
    {
#pragma unroll
        for (int i = 0; i < 8; ++i) kf[i] = kfrag(lds + KRING, kb, i);
        const f32x16 z = {};
#pragma unroll
        for (int i = 0; i < 8; ++i) { if ((i & 1) == 0) sA0 = AMFMA(kf[i], qr[i >> 1], (i >> 1) == 0 ? z : sA0, 0, 0, 0); else sA1 = AMFMA(kf[i], qr[i >> 1], (i >> 1) == 0 ? z : sA1, 0, 0, 0); }
        if (shift > 0.f) {
#pragma unroll
            for (int r = 0; r < 16; ++r) { sA0[r] -= shift; sA1[r] -= shift; } }
#pragma unroll
        for (int r = 0; r < 16; ++r) { sA0[r] = __builtin_amdgcn_exp2f(sA0[r]); sA1[r] = __builtin_amdgcn_exp2f(sA1[r]); }
#pragma unroll
        for (int i = 0; i < 8; ++i) kf[i] = kfrag(lds + KRING + RSLOT, kb, i);
    }
#define ATOP() do { asm volatile("s_waitcnt vmcnt(0)" ::: "memory"); __builtin_amdgcn_s_barrier(); asm volatile("" ::: "memory"); ASBAR(); } while (0)
#define ASTEP(C0, C1, P0, P1, t, GL, ISSUE) do { \
        const ALAS char* vp_ = vbase + (((t) - 1) & 3) * RSLOT; const ALAS char* kn_ = lds + KRING + (((t) + 1) & 3) * RSLOT; float sacc = 0.f; \
        gapA<0>(C0, C1, P0, P1, kf, qr, sacc, pw, vlo, vhi, vp_); gapA<1>(C0, C1, P0, P1, kf, qr, sacc, pw, vlo, vhi, vp_); \
        gapA<2>(C0, C1, P0, P1, kf, qr, sacc, pw, vlo, vhi, vp_); gapA<3>(C0, C1, P0, P1, kf, qr, sacc, pw, vlo, vhi, vp_); \
        gapA<4>(C0, C1, P0, P1, kf, qr, sacc, pw, vlo, vhi, vp_); gapA<5>(C0, C1, P0, P1, kf, qr, sacc, pw, vlo, vhi, vp_); \
        gapA<6>(C0, C1, P0, P1, kf, qr, sacc, pw, vlo, vhi, vp_); gapA<7>(C0, C1, P0, P1, kf, qr, sacc, pw, vlo, vhi, vp_); \
        l += sacc; \
        if (shift > 0.f) { _Pragma("unroll") for (int r = 0; r < 16; ++r) { C0[r] -= shift; C1[r] -= shift; } } \
        ASBAR(); \
        if (ISSUE) { if ((t) + 1 < NT) VDMA((t) + 1); if ((t) + 2 < NT) VDMA((t) + 2); if ((t) + 3 < NT) KDMA((t) + 3); if ((t) + 4 < NT) KDMA((t) + 4); } \
        ASBAR(); \
        gapB<0, GL>(o, C0, C1, kf, pw, vlo, vhi, vp_, kn_, kb); gapB<1, GL>(o, C0, C1, kf, pw, vlo, vhi, vp_, kn_, kb); gapB<2, GL>(o, C0, C1, kf, pw, vlo, vhi, vp_, kn_, kb); gapB<3, GL>(o, C0, C1, kf, pw, vlo, vhi, vp_, kn_, kb); \
        gapB<4, GL>(o, C0, C1, kf, pw, vlo, vhi, vp_, kn_, kb); gapB<5, GL>(o, C0, C1, kf, pw, vlo, vhi, vp_, kn_, kb); gapB<6, GL>(o, C0, C1, kf, pw, vlo, vhi, vp_, kn_, kb); gapB<7, GL>(o, C0, C1, kf, pw, vlo, vhi, vp_, kn_, kb); \
        gapB<8, GL>(o, C0, C1, kf, pw, vlo, vhi, vp_, kn_, kb); gapB<9, GL>(o, C0, C1, kf, pw, vlo, vhi, vp_, kn_, kb); gapB<10, GL>(o, C0, C1, kf, pw, vlo, vhi, vp_, kn_, kb); gapB<11, GL>(o, C0, C1, kf, pw, vlo, vhi, vp_, kn_, kb); \
        gapB<12, GL>(o, C0, C1, kf, pw, vlo, vhi, vp_, kn_, kb); gapB<13, GL>(o, C0, C1, kf, pw, vlo, vhi, vp_, kn_, kb); gapB<14, GL>(o, C0, C1, kf, pw, vlo, vhi, vp_, kn_, kb); gapB<15, GL>(o, C0, C1, kf, pw, vlo, vhi, vp_, kn_, kb); \
    } while (0)
    for (int t = 1; t + 1 < NT; t += 2) { ATOP(); ASTEP(sB0, sB1, sA0, sA1, t, true, true); ASTEP(sA0, sA1, sB0, sB1, t + 1, true, false); }
    ATOP(); ASTEP(sB0, sB1, sA0, sA1, NT - 1, false, false);
#undef ASTEP
#undef ATOP
    {
        float sacc = 0.f;
#pragma unroll
        for (int r = 0; r < 16; ++r) sacc += sB0[r] + sB1[r];
        l += sacc;
#pragma unroll
        for (int ks = 0; ks < 4; ++ks)
#pragma unroll
            for (int e = 0; e < 4; ++e) { const int b0 = (8 * ks + 2 * e) & 15; pw[ks][e] = (ks < 2) ? cvtpk_s(sB0[b0], sB0[b0 + 1]) : cvtpk_s(sB1[b0], sB1[b0 + 1]); }
        const ALAS char* vp_ = vbase + ((NT - 1) & 3) * RSLOT;
#pragma unroll
        for (int f = 0; f < 16; ++f) { vlo[f] = vtr(vp_ + vfoff(f)); vhi[f] = vtr(vp_ + vfoff(f) + 2048); o[f & 3] = AMFMA(__builtin_bit_cast(bf16x8, pw[f >> 2]), VFRAG(f), o[f & 3], 0, 0, 0); }
    }
    { auto rr = __builtin_amdgcn_permlane32_swap(__float_as_uint(l), __float_as_uint(l), false, false); l = __uint_as_float(rr[0]) + __uint_as_float(rr[1]); }
    ALAS float* scr = (ALAS float*)(lds + SCR_OFF) + wid * 32;
    if (hi == 0) scr[r32] = (mp == 0 ? 1.0f : lam) / l;
    asm volatile("s_waitcnt lgkmcnt(0)" ::: "memory");
    __builtin_amdgcn_s_barrier(); asm volatile("" ::: "memory");
    const bool has_next = it + 1 < nu;
    int nbh = bh, nqb = qb;
    if (has_next) {
        um.get(it + 1, nbh, nqb);
        const size_t nrow = (size_t)(nbh >> 3) * SEQ; const bf16_t* nKh = K + (size_t)nbh * 262144;
        KDMA_(nKh, 0); KDMA_(nKh, 1); KDMA_(nKh, 2); KDMA_(nKh, 3);
    }
    ALAS float* xch = (ALAS float*)(lds + VRING) + rg * 4096;
    if (mp == 1) {
#pragma unroll
        for (int r = 0; r < 16; ++r) { const float bb = scr[crow(r, hi)];
#pragma unroll
            for (int d = 0; d < 4; ++d) xch[(r * 4 + d) * 64 + lane] = o[d][r] * bb; }
    }
    asm volatile("s_waitcnt lgkmcnt(0)" ::: "memory");
    __builtin_amdgcn_s_barrier(); asm volatile("" ::: "memory");
    if (mp == 0) {
        ALAS char* stg = lds + STG_OFF + rg * STG_RG;
        bf16_t* Og = O + (rowbase + q0 + rg * 32) * D_MODEL + h * 128;
#pragma unroll
        for (int half = 0; half < 2; ++half) {
#pragma unroll
            for (int rr = 0; rr < 8; ++rr) {
                const int r = half * 8 + rr; const int orow = crow(r, hi); const float a = scr[orow];
                float v[4]; float ss = 0.f;
#pragma unroll
                for (int d = 0; d < 4; ++d) { v[d] = o[d][r] * a - xch[(r * 4 + d) * 64 + lane]; ss += v[d] * v[d]; }
                ss = xsum16(rowsum16(ss));
                const float rs = __builtin_amdgcn_rsqf(ss * (1.0f / 128.0f) + EPS);
                const int srow = orow - 16 * half;
#pragma unroll
                for (int d = 0; d < 4; ++d) *(ALAS unsigned short*)(stg + srow * STG_PITCH + (d * 32 + r32) * 2) = (unsigned short)(cvtpk_s(v[d] * rs, 0.f) & 0xffffu);
            }
            asm volatile("s_waitcnt lgkmcnt(0)" ::: "memory");
#pragma unroll
            for (int i = 0; i < 4; ++i) { const int srow = i * 4 + (lane >> 4), ch = lane & 15;
                const u32x4 w = *(const ALAS u32x4*)(stg + srow * STG_PITCH + ch * 16);
                *(u32x4*)(Og + (size_t)(16 * half + srow) * D_MODEL + ch * 8) = w; }
            asm volatile("s_waitcnt lgkmcnt(0)" ::: "memory");
        }
    }
    asm volatile("s_waitcnt lgkmcnt(0)" ::: "memory");
    __builtin_amdgcn_s_barrier(); asm volatile("" ::: "memory");
    if (has_next) { const size_t nrow = (size_t)(nbh >> 3) * SEQ; const bf16_t* nVh = V + (size_t)nbh * 262144;
        const bf16_t* Qw = Q + (nrow + nqb * 128 + rg * 32 + r32) * D_MODEL + (nbh & 7) * 128 + mp * 64 + hi * 8;
#pragma unroll
        for (int d0 = 0; d0 < 4; ++d0) qr[d0] = *(const bf16x8*)(Qw + d0 * 16);
        asm volatile("" ::: "memory");
        VDMA_(nVh, 0); VDMA_(nVh, 1); }
    bh = nbh; qb = nqb;
    }
    asm volatile("s_waitcnt vmcnt(0)" ::: "memory");
#undef KDMA
#undef VDMA
#undef KDMA_
#undef VDMA_
#undef AGLDS16
}
}

constexpr size_t MiB = 1u << 20;
constexpr size_t WS_CTL = 0, CTL_ZERO_BYTES = 64 * 1024;
constexpr size_t WS_SSQ = 406 * MiB;
constexpr size_t WS_SCAL = 2 * MiB - 4096;
constexpr size_t WS_ROPE = 2 * MiB;
constexpr size_t WS_WQKV = 4 * MiB, WS_WO = 16 * MiB, WS_WP = 20 * MiB, WS_W1 = 22 * MiB, WS_W2 = 54 * MiB;
constexpr size_t WS_XB = 86 * MiB;
constexpr size_t WS_BIG = 150 * MiB;
constexpr size_t WS_Q = WS_BIG, WS_K = WS_BIG + 64 * MiB, WS_V = WS_BIG + 128 * MiB, WS_END = WS_BIG + 256 * MiB;
constexpr size_t WS_TOTAL = WS_SSQ + 9 * (size_t)M * 64;

constexpr int RING_BYTES = 131072, MISC_OFF = RING_BYTES + 320, LDS_BYTES = 151552;
static_assert(att::ATT_LDS <= RING_BYTES && pg8::STAGE_BYTES <= RING_BYTES && att::ATT_LDS_TOP <= LDS_BYTES, "LDS map");

#define LAS __attribute__((address_space(3)))
typedef unsigned short bf16;
typedef unsigned v4u __attribute__((ext_vector_type(4)));
typedef float f32x4 __attribute__((ext_vector_type(4)));
__device__ __forceinline__ unsigned f2bf(float f) { unsigned u = __builtin_bit_cast(unsigned, f); return (u + 0x7fffu + ((u >> 16) & 1u)) >> 16; }
__device__ __forceinline__ unsigned pk2(float lo, float hi) { return f2bf(lo) | (f2bf(hi) << 16); }

#define XB_TMO      128
#define XB_XCNT(j)  (256  + 64 * (j))
#define XB_XSUB(j)  (1280 + 64 * (j))
#define XB_XGEN(j)  (2304 + 64 * (j))
#define XB_TOP      3328
#define XB_TOPGEN   3392
#define XCD_BAR_WORDS 3456
#define XB_SPIN_CAP (1u << 18)
__device__ __forceinline__ unsigned xb_ld(unsigned* p)              { return __hip_atomic_load(p, __ATOMIC_RELAXED, __HIP_MEMORY_SCOPE_AGENT); }
__device__ __forceinline__ unsigned xb_add(unsigned* p, unsigned v) { return __hip_atomic_fetch_add(p, v, __ATOMIC_RELAXED, __HIP_MEMORY_SCOPE_AGENT); }
__device__ __forceinline__ unsigned xb_xcc_id() { return (unsigned)__builtin_amdgcn_s_getreg((3 << 11) | 20) & 0xFu; }
#define XB_SPIN(cond, bar) do { unsigned _sp = 0; while (cond) { __builtin_amdgcn_s_sleep(1); \
    if ((++_sp & 255u) == 0u) { if (xb_ld(&(bar)[XB_TMO])) break; if (_sp > XB_SPIN_CAP) { atomicAdd(&(bar)[XB_TMO], 1u); break; } } } } while (0)
struct XcdBarrier { unsigned* bar; unsigned x; volatile LAS unsigned* st; };
__device__ __forceinline__ XcdBarrier xcd_barrier_post(unsigned* bar, volatile LAS unsigned* st) {
    XcdBarrier b; b.bar = bar; b.x = xb_xcc_id(); b.st = st;
    if (threadIdx.x == 0) (void)xb_add(&bar[XB_XCNT(b.x)], 1u);
    return b;
}
__device__ __forceinline__ void xcd_barrier_complete(unsigned* bar, unsigned x, unsigned& nloc, unsigned& nx) {
    const unsigned G = gridDim.x * gridDim.y * gridDim.z;
    unsigned sum, cnt, mine, sp = 0u;
    for (;;) {
        sum = 0u; cnt = 0u; mine = 0u;
#pragma unroll
        for (unsigned j = 0; j < 16; ++j) { const unsigned c = xb_ld(&bar[XB_XCNT(j)]); sum += c; cnt += (c > 0u) ? 1u : 0u; mine = (j == x) ? c : mine; }
        if (sum == G) break;
        __builtin_amdgcn_s_sleep(1);
        if ((++sp & 255u) == 0u) { if (xb_ld(&bar[XB_TMO])) break; if (sp > XB_SPIN_CAP) { atomicAdd(&bar[XB_TMO], 1u); break; } }
    }
    nloc = mine > 0u ? mine : 1u; nx = cnt > 0u ? cnt : 1u;
}
__device__ __forceinline__ void xcd_barrier(const XcdBarrier& b) {
    asm volatile("s_waitcnt vmcnt(0)" ::: "memory");
    __syncthreads();
    if (threadIdx.x == 0) {
        unsigned* bar = b.bar;
        __builtin_amdgcn_s_waitcnt(0);
        unsigned nloc = b.st[0], nx = b.st[1];
        if (nloc == 0u) { xcd_barrier_complete(bar, b.x, nloc, nx); b.st[0] = nloc; b.st[1] = nx; }
        const unsigned old = xb_add(&bar[XB_XSUB(b.x)], 1u);
        const unsigned gen = old / nloc;
        if (old + 1u == (gen + 1u) * nloc) {
            __builtin_amdgcn_fence(__ATOMIC_RELEASE, "agent");
            asm volatile("s_waitcnt vmcnt(0)" ::: "memory");
            const unsigned og = xb_add(&bar[XB_TOP], 1u);
            const unsigned tg = og / nx;
            if (og + 1u == (tg + 1u) * nx) xb_add(&bar[XB_TOPGEN], 1u);
            else XB_SPIN(xb_ld(&bar[XB_TOPGEN]) == tg, bar);
            __builtin_amdgcn_fence(__ATOMIC_ACQUIRE, "agent");
            xb_add(&bar[XB_XGEN(b.x)], 1u);
            asm volatile("s_waitcnt vmcnt(0)" ::: "memory");
        } else {
            XB_SPIN(xb_ld(&bar[XB_XGEN(b.x)]) == gen, bar);
            __builtin_amdgcn_fence(__ATOMIC_ACQUIRE, "agent");
            asm volatile("s_waitcnt vmcnt(0)" ::: "memory");
        }
    }
    __syncthreads();
}

struct Args {
    const float* x; const int* pos; const float* norm_mix; const float* norm_mlp; const float* w_qkv; const float* w_o;
    const float* q_gain; const float* k_gain; const float* lq1; const float* lk1; const float* lq2; const float* lk2; const float* sub_gain;
    const float* pool_w; const float* pool_scale; const float* w1; const float* w2;
    float* out; unsigned char* ws;
    float lam_init[2]; float inv_freq[8];
    int ph_lo, ph_hi;
};

__device__ __forceinline__ float wave_sum(float v) {
#pragma unroll
    for (int o = 1; o < 64; o <<= 1) v += __shfl_xor(v, o);
    return v;
}
struct WItem { const float* W; int K, N; bf16* WT; int row_off; const float* rsp; int rsmask; float rmul; const float* csp; int item; int mode; };
__device__ __forceinline__ void witem_load(const WItem& d, int lane, float (&v)[32]) {
    const int nblk = d.N / 32, kb = d.item / nblk, nb = d.item % nblk, k0 = 64 * kb, n0 = 32 * nb;
    const float cs = (d.csp ? d.csp[n0 + (lane & 31)] : 1.0f) * d.rmul;
#pragma unroll
    for (int i = 0; i < 32; ++i) { const int kk = 2 * i + (lane >> 5); const float rs = d.rsp ? d.rsp[(k0 + kk) & d.rsmask] : 1.0f;
        v[i] = d.W[(size_t)(k0 + kk) * d.N + n0 + (lane & 31)] * rs * cs; }
}
__device__ __forceinline__ void witem_store(const WItem& d, LAS float* scr, int lane, const float (&v)[32]) {
    const int nblk = d.N / 32, kb = d.item / nblk, nb = d.item % nblk, k0 = 64 * kb, n0 = 32 * nb;
#pragma unroll
    for (int i = 0; i < 32; ++i) scr[(2 * i + (lane >> 5)) * 33 + (lane & 31)] = v[i];
    asm volatile("s_waitcnt lgkmcnt(0)" ::: "memory");
    const int c = lane & 7;
#pragma unroll
    for (int j = 0; j < 4; ++j) { const int n = (lane >> 3) + 8 * j; const LAS float* s = scr + (8 * c) * 33 + n;
        v4u o; o.x = pk2(s[0 * 33], s[1 * 33]); o.y = pk2(s[2 * 33], s[3 * 33]); o.z = pk2(s[4 * 33], s[5 * 33]); o.w = pk2(s[6 * 33], s[7 * 33]);
        const int ng = d.row_off + n0 + n, pn = ng >> 8, nl = ng & 255, x = nl & 31, rho = 16 * ((x >> 2) & 1) + 4 * (x >> 3) + (x & 3);
        const int h = d.mode ? ((nl >> 5) & 1) : (nl >> 7), R = d.mode ? (32 * (nl >> 6) + rho) : (((nl & 127) & ~31) + rho);
        const size_t byte = (((size_t)pn * (d.K / 64) + kb) * 2 + h) * 16384 + (size_t)pg8::lds_byte(R, 8 * c);
        *(v4u*)((char*)d.WT + byte) = o; }
    asm volatile("s_waitcnt lgkmcnt(0)" ::: "memory");
}

typedef const __attribute__((address_space(4))) Args* CArgs;
__device__ __forceinline__ CArgs argp() { CArgs p = (CArgs)__builtin_amdgcn_kernarg_segment_ptr(); asm volatile("" : "+s"(p)); return p; }

__global__ void __launch_bounds__(512, 2) fwd_megakernel(Args a_) {
    extern __shared__ __attribute__((aligned(16))) unsigned char lds_raw[];
    LAS unsigned char* lds = (LAS unsigned char*)lds_raw;
    volatile LAS unsigned* MISC = (volatile LAS unsigned*)(lds + MISC_OFF);
    const int tid = threadIdx.x, lane = tid & 63, wave = __builtin_amdgcn_readfirstlane(tid >> 6);
    const int G = gridDim.x, bx = blockIdx.x, vcu0 = (G % 8 == 0) ? (bx % 8) * (G / 8) + bx / 8 : bx;
    unsigned* ctl; { const CArgs ap = argp(); ctl = (unsigned*)(ap->ws + WS_CTL); }
#define PHASE_VARS const CArgs ap = argp(); unsigned char* ws = ap->ws; float* ssq = (float*)(ws + WS_SSQ); float* scal = (float*)(ws + WS_SCAL); float* rope = (float*)(ws + WS_ROPE); \
    bf16* Wqkv_t = (bf16*)(ws + WS_WQKV); bf16* Wo_t = (bf16*)(ws + WS_WO); bf16* Wp_t = (bf16*)(ws + WS_WP); bf16* W1_t = (bf16*)(ws + WS_W1); bf16* W2_t = (bf16*)(ws + WS_W2); \
    bf16* XB = (bf16*)(ws + WS_XB); bf16* QB = (bf16*)(ws + WS_Q); bf16* KB = (bf16*)(ws + WS_K); bf16* VB = (bf16*)(ws + WS_V); bf16* HB = (bf16*)(ws + WS_BIG); bf16* DF = (bf16*)(ws + WS_BIG); \
    (void)ssq; (void)scal; (void)rope; (void)Wqkv_t; (void)Wo_t; (void)Wp_t; (void)W1_t; (void)W2_t; (void)XB; (void)QB; (void)KB; (void)VB; (void)HB; (void)DF;
#define LAYER_VARS const float* ssq_in = ssq + (size_t)(2 * i) * M * 16; float* ssq_mix = ssq + (size_t)(2 * i + 1) * M * 16; float* ssq_mlp = ssq + (size_t)(2 * i + 2) * M * 16; \
    const float* xbase = (i == 0) ? ap->x : ap->out; (void)ssq_in; (void)ssq_mix; (void)ssq_mlp; (void)xbase;
    for (int u = tid; u < (LDS_BYTES - RING_BYTES) / 4; u += 512) ((LAS unsigned*)(lds + RING_BYTES))[u] = 0u;
    __syncthreads();
    XcdBarrier bar; bar.bar = ctl + 4096; bar.x = 0; bar.st = nullptr;
#if !MK_PER_PHASE
    bar = xcd_barrier_post(ctl + 4096, MISC + 8);
#endif
    int lo, hi; { const CArgs ap = argp(); lo = ap->ph_lo; hi = ap->ph_hi; } int ph = 0;
#if !MK_PER_PHASE
    if (tid == 0) { const unsigned xcc = xb_xcc_id(); MISC[16] = xcc; MISC[17] = xb_add(ctl + 1024 + 64 * xcc, 1u); }
#endif
#if MK_PER_PHASE
#define SEAM() do { ++ph; } while (0)
#else
#define SEAM() do { if (ph == 0 && MK_CG_FIRST) { cg::this_grid().sync(); } else { xcd_barrier(bar); } ++ph; } while (0)
#endif
#define RUN (ph >= lo && ph < hi)

    if (RUN) { PHASE_VARS
        LAS float* scr = (LAS float*)(lds + wave * 16384);
        const int gw = vcu0 * 8 + wave, NGW = G * 8;
        constexpr int I_QKV = (D_MODEL / 64) * (3 * D_MODEL / 32), I_O = (D_MODEL / 64) * (D_MODEL / 32), I_1 = (D_MODEL / 64) * (FF / 32), I_2 = (FF / 64) * (D_MODEL / 32), I_P = (256 / 64) * (256 / 32);
        constexpr int NITEMS = 2 * I_QKV + 2 * I_O + 4 * I_1 + 4 * I_2 + 8 * I_P;
        auto decode = [&](int it) -> WItem {
            int r = it;
            if (r < 2 * I_QKV) { const int j = r / I_QKV; r -= j * I_QKV;
                return WItem{ap->w_qkv + (size_t)j * D_MODEL * 3 * D_MODEL, D_MODEL, 3 * D_MODEL, Wqkv_t + (size_t)j * 3 * D_MODEL * D_MODEL, 0, ap->norm_mix + (2 * j) * D_MODEL, D_MODEL - 1, 1.0f, nullptr, r, 1}; }
            r -= 2 * I_QKV;
            if (r < 2 * I_O) { const int j = r / I_O; r -= j * I_O;
                return WItem{ap->w_o + (size_t)j * D_MODEL * D_MODEL, D_MODEL, D_MODEL, Wo_t + (size_t)j * D_MODEL * D_MODEL, 0, ap->sub_gain + j * 128, 127, 1.0f - ap->lam_init[j], nullptr, r, 0}; }
            r -= 2 * I_O;
            if (r < 4 * I_1) { const int i = r / I_1; r -= i * I_1;
                return WItem{ap->w1 + (size_t)i * D_MODEL * FF, D_MODEL, FF, W1_t + (size_t)i * D_MODEL * FF, 0, ap->norm_mlp + i * D_MODEL, D_MODEL - 1, 1.0f, nullptr, r, 0}; }
            r -= 4 * I_1;
            if (r < 4 * I_2) { const int i = r / I_2; r -= i * I_2;
                return WItem{ap->w2 + (size_t)i * D_MODEL * FF, FF, D_MODEL, W2_t + (size_t)i * D_MODEL * FF, 0, nullptr, 0, 1.0f, nullptr, r, 0}; }
            r -= 4 * I_2;
            const int jg = r / I_P; r -= jg * I_P; const int j = jg >> 2, g = jg & 3;
            return WItem{ap->pool_w + (size_t)jg * 65536, 256, 256, Wp_t + (size_t)j * 1024 * 256, 256 * g, ap->norm_mix + (2 * j + 1) * D_MODEL + 256 * g, 255, 1.0f, ap->pool_scale + j * D_MODEL + 256 * g, r, 0};
        };
        {
            float va[32], vb[32];
            int it = gw;
            if (it < NITEMS) witem_load(decode(it), lane, va);
            while (it < NITEMS) {
                const int it1 = it + NGW, it2 = it + 2 * NGW;
                if (it1 < NITEMS) witem_load(decode(it1), lane, vb);
                witem_store(decode(it), scr, lane, va);
                if (it1 >= NITEMS) break;
                if (it2 < NITEMS) witem_load(decode(it2), lane, va);
                witem_store(decode(it1), scr, lane, vb);
                it = it2;
            }
        }
        float* ssq0 = ssq;
        for (int m0 = gw; m0 < M; m0 += 4 * NGW) {
            f32x4 v[4][4]; float sq[4];
#pragma unroll
            for (int q = 0; q < 4; ++q) { const int m = m0 + q * NGW; const f32x4* xr = (const f32x4*)(ap->x + (size_t)(m < M ? m : m0) * D_MODEL) + lane;
#pragma unroll
                for (int j = 0; j < 4; ++j) v[q][j] = xr[64 * j]; }
#pragma unroll
            for (int q = 0; q < 4; ++q) { float s = 0.f;
#pragma unroll
                for (int j = 0; j < 4; ++j) s += (v[q][j].x * v[q][j].x + v[q][j].y * v[q][j].y) + (v[q][j].z * v[q][j].z + v[q][j].w * v[q][j].w);
                sq[q] = wave_sum(s); }
#pragma unroll
            for (int q = 0; q < 4; ++q) { const int m = m0 + q * NGW; if (m < M) {
#pragma unroll
                for (int j = 0; j < 4; ++j) *(unsigned long long*)(XB + pg8::aimg_off(m, 4 * lane + 256 * j, D_MODEL / 64)) = (unsigned long long)pk2(v[q][j].x, v[q][j].y) | ((unsigned long long)pk2(v[q][j].z, v[q][j].w) << 32);
                if (lane < 16) ssq0[(size_t)m * 16 + lane] = (lane == 0) ? sq[q] : 0.0f;
                if (lane < 8) {
                    const float ang = (float)ap->pos[m] * ap->inv_freq[lane];
                    double rev = (double)ang * 0.15915494309189535; rev -= floor(rev);
                    const float rv = (float)rev;
                    rope[(size_t)m * 16 + lane] = __builtin_amdgcn_cosf(rv); rope[(size_t)m * 16 + 8 + lane] = __builtin_amdgcn_sinf(rv);
                } } }
        }
        if (gw == 0 && lane < 2) {
            const int j = lane; float d1 = 0.f, d2 = 0.f, mq = 0.f, mk = 0.f;
            for (int i = 0; i < 64; ++i) { d1 += ap->lq1[j * 64 + i] * ap->lk1[j * 64 + i]; d2 += ap->lq2[j * 64 + i] * ap->lk2[j * 64 + i];
                mq = fmaxf(mq, fabsf(ap->q_gain[j * 64 + i])); mk = fmaxf(mk, fabsf(ap->k_gain[j * 64 + i])); }
            scal[j] = __expf(d1) - __expf(d2) + ap->lam_init[j];
            const float bound = 8.0f * 1.4426950408889634f * mq * mk * 1.01f;
            scal[2 + j] = bound > 64.0f ? bound - 64.0f : 0.0f;
        }
    }
    SEAM();
    int vcu = vcu0, cord = bx;
#if !MK_PER_PHASE
    if (tid == 0) { const unsigned xcc = MISC[16]; unsigned base = 0u; for (unsigned jx = 0; jx < xcc; ++jx) base += xb_ld(ctl + 1024 + 64 * jx); MISC[18] = base + MISC[17]; }
    __syncthreads();
    vcu = (int)MISC[18]; if (G % 8 == 0) cord = (vcu % (G / 8)) * 8 + vcu / (G / 8);
    vcu = __builtin_amdgcn_readfirstlane(vcu); cord = __builtin_amdgcn_readfirstlane(cord);
#endif

    for (int i = 0; i < DEPTH; ++i) {
        const int j = i >> 1;
        if ((i & 1) == 0) {
            if (RUN) { PHASE_VARS LAYER_VARS
                pg8::Gemm g{XB, Wqkv_t + (size_t)j * 3 * D_MODEL * D_MODEL, M, 3 * D_MODEL, D_MODEL, D_MODEL, 0, 1}; pg8::StaticOrder S; S.init(M, 3 * D_MODEL, G, cord);
                pg8::EpiQKV E{QB, (size_t)(WS_K - WS_Q) / 2, ssq_in, rope, ap->q_gain + j * 64, ap->k_gain + j * 64, 0.125f * 1.4426950408889634f};
#ifndef SKIP_QKV
                pg8::gemm_phase<pg8::EpiQKV, pg8::StaticOrder>(lds, (LAS float*)(lds + att::STG_OFF), g, S, E);
#endif
            }
            SEAM();
            if (RUN) { PHASE_VARS
                const float lam = scal[j], shift = scal[2 + j];
                const int xcd = vcu >> 5, c = vcu & 31;
#ifndef SKIP_ATT
                { const att::UnitMap um{G == 256 ? 1 : 0, xcd, c, bx, G};
                  att::attn_units(um, QB, KB, VB, QB, (ALAS char*)lds, shift, lam); }
#endif
            }
            SEAM();
        } else {
            if (RUN) { PHASE_VARS LAYER_VARS
                LAS float* tile = (LAS float*)lds;
                for (int it = bx; it < (M / 64) * 4; it += G) {
                    const int g = ((it & 3) + (it >> 8)) & 3, t0 = (it >> 2) * 64, hw = 1 << g, s0 = t0 & (SEQ - 1), tb = t0 - s0;
                    const int rlo = (s0 - hw < 0) ? 0 : s0 - hw, rhi = (s0 + 64 + hw > SEQ) ? SEQ : s0 + 64 + hw, nrows = rhi - rlo;
                    const int col = 256 * g + 4 * lane;
                    {
                        unsigned long long xw[12]; float rsv[12];
#pragma unroll
                        for (int k = 0; k < 12; ++k) { const int r = wave + 8 * k; const int t = tb + rlo + (r < nrows ? r : 0);
                            xw[k] = *(const unsigned long long*)(XB + pg8::aimg_off(t, col, D_MODEL / 64)); rsv[k] = pg8::rstd_row(ssq_in, t); }
#pragma unroll
                        for (int k = 0; k < 12; ++k) { const int r = wave + 8 * k;
                            if (r < nrows) { f32x4 xv; xv[0] = __uint_as_float((unsigned)xw[k] << 16); xv[1] = __uint_as_float((unsigned)xw[k] & 0xffff0000u); xv[2] = __uint_as_float((unsigned)(xw[k] >> 32) << 16); xv[3] = __uint_as_float((unsigned)(xw[k] >> 32) & 0xffff0000u);
                                *(LAS f32x4*)(tile + r * 256 + 4 * lane) = xv * rsv[k]; } }
                    }
                    __syncthreads();
#pragma unroll 2
                    for (int k = 0; k < 8; ++k) {
                        const int s = s0 + wave + 8 * k;
                        const int wlo = (s - hw < 0) ? 0 : s - hw, whi = (s + hw > SEQ) ? SEQ : s + hw;
                        f32x4 acc = {0.f, 0.f, 0.f, 0.f};
                        for (int u = wlo; u < whi; ++u) acc += *(const LAS f32x4*)(tile + (u - rlo) * 256 + 4 * lane);
                        const f32x4 ctr = *(const LAS f32x4*)(tile + (s - rlo) * 256 + 4 * lane);
                        const float inv = 1.0f / (float)(whi - wlo);
                        const f32x4 d = acc * inv - ctr;
                        *(unsigned long long*)(DF + (size_t)(tb + s) * D_MODEL + col) = (unsigned long long)pk2(d.x, d.y) | ((unsigned long long)pk2(d.z, d.w) << 32);
                    }
                    __syncthreads();
                }
            }
            SEAM();
        }
        if (RUN) { PHASE_VARS LAYER_VARS
            pg8::Gemm g;
            if ((i & 1) == 0) g = pg8::Gemm{QB, Wo_t + (size_t)j * D_MODEL * D_MODEL, M, D_MODEL, D_MODEL, D_MODEL, 0, 0};
            else              g = pg8::Gemm{DF, Wp_t + (size_t)j * 1024 * 256, M, D_MODEL, 256, D_MODEL, 256, 0};
            pg8::StaticOrder S; S.init(M, D_MODEL, G, cord);
            pg8::EpiResid E{ap->out, XB, ssq_mix, D_MODEL, false, nullptr};
#ifndef SKIP_MIX
            pg8::gemm_phase<pg8::EpiResid, pg8::StaticOrder>(lds, (LAS float*)(lds + att::STG_OFF), g, S, E);
#endif
        }
        SEAM();
        if (RUN) { PHASE_VARS LAYER_VARS
            pg8::Gemm g{XB, W1_t + (size_t)i * D_MODEL * FF, M, FF, D_MODEL, D_MODEL, 0, 1}; pg8::StaticOrder S; S.init(M, FF, G, cord);
            pg8::EpiUp E{HB, FF, ssq_mix};
#ifndef SKIP_UP
            pg8::gemm_phase<pg8::EpiUp, pg8::StaticOrder>(lds, (LAS float*)(lds + att::STG_OFF), g, S, E);
#endif
        }
        SEAM();
        if (RUN) { PHASE_VARS LAYER_VARS
            pg8::Gemm g{HB, W2_t + (size_t)i * D_MODEL * FF, M, D_MODEL, FF, FF, 0, 1}; pg8::StaticOrder S; S.init(M, D_MODEL, G, cord);
            pg8::EpiResid E{ap->out, XB, ssq_mlp, D_MODEL, i == DEPTH - 1, ssq_mix};
#ifndef SKIP_DOWN
            pg8::gemm_phase<pg8::EpiResid, pg8::StaticOrder>(lds, (LAS float*)(lds + att::STG_OFF), g, S, E);
#endif
        }
        if (i < DEPTH - 1) SEAM();
    }
#undef SEAM
#undef RUN
}

constexpr int N_PHASES = 1 + 2 * 5 + 2 * 4;
extern "C" void kernel_launch(void* const* d_in, const int* in_sizes, int n_in, void* d_out, int out_size, void* d_ws, size_t ws_size, hipStream_t stream) {
    static int grid = 0;
    if (grid == 0) {
        if (n_in != 17 || in_sizes[0] != M * D_MODEL || out_size != M * D_MODEL || ws_size < WS_TOTAL) {
            fprintf(stderr, "kernel_launch: unexpected shapes: n_in %d in0 %d out %d ws %zu (need >= %zu)\n", n_in, n_in > 0 ? in_sizes[0] : -1, out_size, ws_size, (size_t)WS_TOTAL); grid = -1; return; }
        int dev = 0, cus = 0, per_cu = 0;
        if (hipGetDevice(&dev) != hipSuccess || hipDeviceGetAttribute(&cus, hipDeviceAttributeMultiprocessorCount, dev) != hipSuccess) { grid = -1; return; }
        if (hipFuncSetAttribute((const void*)fwd_megakernel, hipFuncAttributeMaxDynamicSharedMemorySize, LDS_BYTES) != hipSuccess) { fprintf(stderr, "kernel_launch: hipFuncSetAttribute failed\n"); grid = -1; return; }
        if (hipOccupancyMaxActiveBlocksPerMultiprocessor(&per_cu, (const void*)fwd_megakernel, 512, LDS_BYTES) != hipSuccess || per_cu < 1) { fprintf(stderr, "kernel_launch: occupancy query gave %d\n", per_cu); per_cu = 1; }
        (void)hipGetLastError();
        grid = cus;
    }
    if (grid < 0) return;
    (void)hipMemsetAsync((char*)d_ws + WS_CTL, 0, CTL_ZERO_BYTES, stream);
    Args a{};
    a.x = (const float*)d_in[0]; a.pos = (const int*)d_in[1]; a.norm_mix = (const float*)d_in[2]; a.norm_mlp = (const float*)d_in[3];
    a.w_qkv = (const float*)d_in[4]; a.w_o = (const float*)d_in[5]; a.q_gain = (const float*)d_in[6]; a.k_gain = (const float*)d_in[7];
    a.lq1 = (const float*)d_in[8]; a.lk1 = (const float*)d_in[9]; a.lq2 = (const float*)d_in[10]; a.lk2 = (const float*)d_in[11]; a.sub_gain = (const float*)d_in[12];
    a.pool_w = (const float*)d_in[13]; a.pool_scale = (const float*)d_in[14]; a.w1 = (const float*)d_in[15]; a.w2 = (const float*)d_in[16];
    a.out = (float*)d_out; a.ws = (unsigned char*)d_ws;
    a.lam_init[0] = (float)(0.8 - 0.6 * exp(-0.3 * 0.0)); a.lam_init[1] = (float)(0.8 - 0.6 * exp(-0.3 * 2.0));
    for (int i = 0; i < 8; ++i) a.inv_freq[i] = powf(500000.0f, -(float)(2 * i) / 16.0f);
#if MK_PER_PHASE
    for (int p = 0; p < N_PHASES; ++p) { a.ph_lo = p; a.ph_hi = p + 1; hipLaunchKernelGGL(fwd_megakernel, dim3(grid), dim3(512), LDS_BYTES, stream, a); }
#else
    a.ph_lo = 0; a.ph_hi = 1 << 30;
    void* args[] = {&a};
    const hipError_t e = hipLaunchCooperativeKernel((const void*)fwd_megakernel, dim3(grid), dim3(512), args, LDS_BYTES, stream);
    if (e != hipSuccess) fprintf(stderr, "kernel_launch: cooperative launch failed: %s (grid %d)\n", hipGetErrorString(e), grid);
#endif
}
```
